# Optimizing an MI355X kernel written in HIP

```python
import math
import jax, jax.numpy as jnp
from jax import lax
import numpy as np

D_MODEL = 1024
BATCH = 8
SEQ = 2048
DEPTH = 1

N_META = 16
N_DIFF_HEADS = 8
HEAD_DIM = 64
V_DIM = 2 * HEAD_DIM
QK_WIDTH = N_DIFF_HEADS * 2 * HEAD_DIM
ATTN_WIDTH = N_DIFF_HEADS * V_DIM
POOL_WINDOWS = (2, 4, 8, 16)
N_POOL_GROUPS = len(POOL_WINDOWS)
POOL_GROUP_DIM = 128
POOL_WIDTH = N_POOL_GROUPS * POOL_GROUP_DIM
N_BRANCHES = 2
GATE_WIDTH = N_BRANCHES * D_MODEL
IN_WIDTH = 2 * QK_WIDTH + ATTN_WIDTH + POOL_WIDTH + GATE_WIDTH
ROPE_THETA = 10000.0
Q_BLOCK = 128
N_GROUPS = 4
EXPERTS_PER_GROUP = 4
N_EXPERTS = N_GROUPS * EXPERTS_PER_GROUP
TOP_K = 2
D_EXPERT = 512
EPS = 1e-6

kernel_name = "hybrid_diffattn_pool_hmoe_block"


def rmsnorm(x, g):
    xf = x.astype(jnp.float32)
    y = xf * lax.rsqrt(jnp.mean(xf * xf, axis=-1, keepdims=True) + EPS)
    return (y * g.astype(jnp.float32)).astype(x.dtype)


def rope_tables(T, dtype):
    inv = 1.0 / (ROPE_THETA ** (jnp.arange(0, HEAD_DIM, 2, dtype=jnp.float32) / HEAD_DIM))
    ang = jnp.arange(T, dtype=jnp.float32)[:, None] * inv[None, :]
    ang = jnp.concatenate([ang, ang], axis=-1)
    return jnp.cos(ang).astype(dtype), jnp.sin(ang).astype(dtype)


def apply_rope(x, cos, sin):
    half = HEAD_DIM // 2
    rot = jnp.concatenate([-x[..., half:], x[..., :half]], axis=-1)
    c = cos[None, :, None, None, :]
    s = sin[None, :, None, None, :]
    return x * c + rot * s


def diff_attention(q, k, v, lam):
    B, T, H = q.shape[0], q.shape[1], q.shape[2]
    n_blk = -(-T // Q_BLOCK)
    Tp = n_blk * Q_BLOCK
    pad5 = ((0, 0), (0, Tp - T), (0, 0), (0, 0), (0, 0))
    q = jnp.pad(q, pad5)
    k = jnp.pad(k, pad5)
    v = jnp.pad(v, pad5[:4])
    scale = 1.0 / math.sqrt(HEAD_DIM)
    key_pos = jnp.arange(Tp)

    def block(i):
        start = i * Q_BLOCK
        qb = lax.dynamic_slice_in_dim(q, start, Q_BLOCK, axis=1)
        s = jnp.einsum('bqhcd,bkhcd->bhcqk', qb, k).astype(jnp.float32) * scale
        q_pos = start + jnp.arange(Q_BLOCK)
        mask = key_pos[None, :] <= q_pos[:, None]
        s = jnp.where(mask[None, None, None], s, -jnp.inf)
        p = jax.nn.softmax(s, axis=-1)
        a = p[:, :, 0] - lam * p[:, :, 1]
        return jnp.einsum('bhqk,bkhe->bqhe', a.astype(v.dtype), v)

    out = lax.map(block, jnp.arange(n_blk))
    out = jnp.moveaxis(out, 0, 1).reshape(B, Tp, H, V_DIM)
    return out[:, :T]


def multiscale_pool(u, pool_w, pool_scale):
    B, T, G, C = u.shape
    uf = u.astype(jnp.float32)
    cs = jnp.pad(lax.cumsum(uf, axis=1), ((0, 0), (1, 0), (0, 0), (0, 0)))
    t = jnp.arange(T)
    means = []
    for g, w in enumerate(POOL_WINDOWS):
        c = cs[:, :, g]
        hi = c[:, 1:]
        lo = jnp.pad(c[:, :T + 1 - w], ((0, 0), (w - 1, 0), (0, 0)))
        cnt = jnp.minimum(t + 1, w).astype(jnp.float32)
        means.append((hi - lo) / cnt[None, :, None])
    mean = jnp.stack(means, axis=2)
    y = (mean - uf).astype(u.dtype)
    y = jnp.einsum('btgc,gcd->btgd', y, pool_w).reshape(B, T, G * C)
    return y * pool_scale


def hier_moe(h, w_rg, b_rg, w_re, b_re, w_gate, w_up, w_down):
    B, T, D = h.shape
    hf = h.reshape(-1, D)
    glog = (hf @ w_rg + b_rg).astype(jnp.float32)
    gprob = jax.nn.softmax(glog, axis=-1)
    gsel = jnp.argmax(glog, axis=-1)
    p_group = jnp.take_along_axis(gprob, gsel[:, None], axis=1)
    elog = (hf @ w_re + b_re).astype(jnp.float32).reshape(-1, N_GROUPS, EXPERTS_PER_GROUP)
    elog_g = jnp.take_along_axis(elog, gsel[:, None, None], axis=1)[:, 0]
    top_v, top_i = lax.top_k(elog_g, TOP_K)
    w2 = jax.nn.softmax(top_v, axis=-1) * p_group
    eidx = gsel[:, None] * EXPERTS_PER_GROUP + top_i
    combine = jnp.sum(jax.nn.one_hot(eidx, N_EXPERTS, dtype=jnp.float32) * w2[..., None], axis=1)
    combine = combine.astype(h.dtype)
    y = jnp.zeros_like(hf)
    for e in range(N_EXPERTS):
        a = jax.nn.silu(hf @ w_gate[e]) * (hf @ w_up[e])
        y = y + combine[:, e:e + 1] * (a @ w_down[e])
    return y.reshape(B, T, D)


def setup_inputs(seed: int = 0) -> dict:
    key = jax.random.key(seed)
    ks = jax.random.split(key, 24)
    f32 = jnp.float32
    nrm = lambda k, shape, s: jax.random.normal(k, shape, f32) * s
    L = DEPTH
    return {
        "x": nrm(ks[0], (BATCH, SEQ, D_MODEL), 1.0),
        "meta": nrm(ks[1], (N_META, D_MODEL), 1.0),
        "norm1_g": 1.0 + nrm(ks[2], (L, D_MODEL), 0.02),
        "w_in": nrm(ks[3], (L, D_MODEL, IN_WIDTH), D_MODEL ** -0.5),
        "b_gate": nrm(ks[4], (L, GATE_WIDTH), 0.02),
        "lambda_q1": nrm(ks[5], (L, HEAD_DIM), 0.1),
        "lambda_k1": nrm(ks[6], (L, HEAD_DIM), 0.1),
        "lambda_q2": nrm(ks[7], (L, HEAD_DIM), 0.1),
        "lambda_k2": nrm(ks[8], (L, HEAD_DIM), 0.1),
        "subln_g": 1.0 + nrm(ks[9], (L, V_DIM), 0.02),
        "pool_w": nrm(ks[10], (L, N_POOL_GROUPS, POOL_GROUP_DIM, POOL_GROUP_DIM), POOL_GROUP_DIM ** -0.5),
        "pool_scale": 1.0 + nrm(ks[11], (L, POOL_WIDTH), 0.1),
        "w_attn_br": nrm(ks[12], (L, ATTN_WIDTH, D_MODEL), ATTN_WIDTH ** -0.5),
        "w_pool_br": nrm(ks[13], (L, POOL_WIDTH, D_MODEL), POOL_WIDTH ** -0.5),
        "w_out": nrm(ks[14], (L, D_MODEL, D_MODEL), D_MODEL ** -0.5),
        "norm2_g": 1.0 + nrm(ks[15], (L, D_MODEL), 0.02),
        "w_router_group": nrm(ks[16], (L, D_MODEL, N_GROUPS), D_MODEL ** -0.5),
        "b_router_group": nrm(ks[17], (L, N_GROUPS), 0.01),
        "w_router_expert": nrm(ks[18], (L, D_MODEL, N_EXPERTS), D_MODEL ** -0.5),
        "b_router_expert": nrm(ks[19], (L, N_EXPERTS), 0.01),
        "w_e_gate": nrm(ks[20], (L, N_EXPERTS, D_MODEL, D_EXPERT), D_MODEL ** -0.5),
        "w_e_up": nrm(ks[21], (L, N_EXPERTS, D_MODEL, D_EXPERT), D_MODEL ** -0.5),
        "w_e_down": nrm(ks[22], (L, N_EXPERTS, D_EXPERT, D_MODEL), D_EXPERT ** -0.5),
        "final_g": 1.0 + nrm(ks[23], (D_MODEL,), 0.02),
    }


def reference(x, meta, norm1_g, w_in, b_gate, lambda_q1, lambda_k1, lambda_q2, lambda_k2,
              subln_g, pool_w, pool_scale, w_attn_br, w_pool_br, w_out, norm2_g,
              w_router_group, b_router_group, w_router_expert, b_router_expert,
              w_e_gate, w_e_up, w_e_down, final_g):
    B = x.shape[0]
    h = jnp.concatenate([jnp.broadcast_to(meta[None].astype(x.dtype), (B, N_META, D_MODEL)), x], axis=1)
    T = h.shape[1]
    cos, sin = rope_tables(T, h.dtype)
    o_q, o_k, o_v = 0, QK_WIDTH, 2 * QK_WIDTH
    o_p = o_v + ATTN_WIDTH
    o_g = o_p + POOL_WIDTH

    for l in range(DEPTH):
        lambda_init = 0.8 - 0.6 * math.exp(-0.3 * l)
        hn = rmsnorm(h, norm1_g[l])
        z = hn @ w_in[l]
        q = z[..., o_q:o_k].reshape(B, T, N_DIFF_HEADS, 2, HEAD_DIM)
        k = z[..., o_k:o_v].reshape(B, T, N_DIFF_HEADS, 2, HEAD_DIM)
        v = z[..., o_v:o_p].reshape(B, T, N_DIFF_HEADS, V_DIM)
        u = z[..., o_p:o_g].reshape(B, T, N_POOL_GROUPS, POOL_GROUP_DIM)
        gates = jax.nn.sigmoid(z[..., o_g:] + b_gate[l]).reshape(B, T, N_BRANCHES, D_MODEL)

        q = apply_rope(q, cos, sin)
        k = apply_rope(k, cos, sin)
        lam = (jnp.exp(jnp.sum(lambda_q1[l].astype(jnp.float32) * lambda_k1[l].astype(jnp.float32)))
               - jnp.exp(jnp.sum(lambda_q2[l].astype(jnp.float32) * lambda_k2[l].astype(jnp.float32)))
               + lambda_init)
        a = diff_attention(q, k, v, lam)
        a = rmsnorm(a, subln_g[l]) * (1.0 - lambda_init)
        y_attn = a.reshape(B, T, ATTN_WIDTH) @ w_attn_br[l]

        y_pool = multiscale_pool(u, pool_w[l], pool_scale[l]) @ w_pool_br[l]

        mixed = gates[:, :, 0] * y_attn + gates[:, :, 1] * y_pool
        h = h + mixed @ w_out[l]

        hn2 = rmsnorm(h, norm2_g[l])
        h = h + hier_moe(hn2, w_router_group[l], b_router_group[l], w_router_expert[l],
                         b_router_expert[l], w_e_gate[l], w_e_up[l], w_e_down[l])

    out = rmsnorm(h, final_g)
    return out[:, N_META:]
```

```cpp
#include <hip/hip_runtime.h>
#include <cstdio>
#include <cstdint>

typedef _Float16 h16;
typedef _Float16 h16x2 __attribute__((ext_vector_type(2)));
typedef _Float16 h16x4 __attribute__((ext_vector_type(4)));
typedef _Float16 h16x8 __attribute__((ext_vector_type(8)));
typedef float f32x2 __attribute__((ext_vector_type(2)));
typedef float f32x4 __attribute__((ext_vector_type(4)));
typedef unsigned u32x2 __attribute__((ext_vector_type(2)));
typedef unsigned u32x4 __attribute__((ext_vector_type(4)));

constexpr int NB = 8, SEQ = 2048, NMETA = 16, TT = SEQ + NMETA, DM = 1024;
constexpr int NX = NB * SEQ;
constexpr int MROWS = 16640;
constexpr int NH = 8, HD = 64, VD = 128;
constexpr int IN_W = 5632, O_K = 1024, O_V = 2048, O_P = 3072, O_G = 3584, PW = 512;
constexpr int NE = 16, DE = 512;
constexpr float EPS = 1e-6f;
constexpr float C2 = 0.125f * 1.4426950408889634f;
constexpr float LAMBDA_INIT = 0.2f;

constexpr size_t MiB = 1u << 20;
constexpr size_t WS_CTL = 0, CTL_BYTES = 1 * MiB;
constexpr size_t WS_ROPE = 1 * MiB;
constexpr size_t WS_LAM = 1 * MiB + 768 * 1024;
constexpr size_t WS_TOKW = 2 * MiB;
constexpr size_t WS_LIST = 3 * MiB;
constexpr size_t WS_WIN = 4 * MiB;
constexpr size_t WS_WA = 15 * MiB;
constexpr size_t WS_WEFF = 17 * MiB;
constexpr size_t WS_WOUT = 18 * MiB;
constexpr size_t WS_RA = 20 * MiB;
constexpr size_t WS_RB = WS_RA + 33 * MiB - MiB / 2;
constexpr size_t WS_RC = WS_RB + 33 * MiB - MiB / 2;
constexpr size_t WS_RD = WS_RC + 33 * MiB - MiB / 2;
constexpr size_t WS_RE = WS_RD + 33 * MiB - MiB / 2;
constexpr size_t WS_RF = WS_RE + 16 * MiB + MiB / 4;
constexpr size_t WS_RG = WS_RF + 16 * MiB;
constexpr size_t WS_END = WS_RG + 64 * MiB;
static_assert(WS_END <= 256 * MiB, "workspace map");
constexpr int CW_CNT = 64;

struct Params {
    const float *x, *meta, *norm1_g, *w_in, *b_gate, *lq1, *lk1, *lq2, *lk2, *subln_g, *pool_w, *pool_scale, *w_attn_br, *w_pool_br, *w_out, *norm2_g,
                *w_rg, *b_rg, *w_re, *b_re, *w_eg, *w_eu, *w_ed, *final_g;
    float* out; unsigned char* ws;
};

__device__ __forceinline__ unsigned pk2(float a, float b) { f32x2 v = {a, b}; h16x2 h = __builtin_convertvector(v, h16x2); return __builtin_bit_cast(unsigned, h); }
__device__ __forceinline__ float wave_sum(float v) {
#pragma unroll
    for (int o = 1; o < 64; o <<= 1) v += __shfl_xor(v, o);
    return v;
}
__device__ __forceinline__ float wave_max(float v) {
#pragma unroll
    for (int o = 1; o < 64; o <<= 1) v = fmaxf(v, __shfl_xor(v, o));
    return v;
}
__device__ __forceinline__ int pos_of_row(int r) { return r < NX ? NMETA + (r & (SEQ - 1)) : r - NX; }
__device__ __forceinline__ int row_of_pos(int b, int p) { return p < NMETA ? NX + p : b * SEQ + p - NMETA; }

template <class RowPtr, class Epi>
__device__ __forceinline__ void wgemm64(const RowPtr rowptr, const h16* Bt_tile, int K, int lane, const Epi epi) {
    const int fr = lane & 15, fq = lane >> 4;
    const h16* ap0 = rowptr(fr) + fq * 8; const h16* ap1 = rowptr(16 + fr) + fq * 8; const h16* ap2 = rowptr(32 + fr) + fq * 8; const h16* ap3 = rowptr(48 + fr) + fq * 8;
    const h16* bp = Bt_tile + (size_t)fr * K + fq * 8;
    f32x4 acc[4][4];
#pragma unroll
    for (int m = 0; m < 4; ++m)
#pragma unroll
        for (int n = 0; n < 4; ++n) acc[m][n] = (f32x4){0.f, 0.f, 0.f, 0.f};
#pragma unroll 2
    for (int k0 = 0; k0 < K; k0 += 32) {
        h16x8 a[4], b[4];
        a[0] = *(const h16x8*)(ap0 + k0); a[1] = *(const h16x8*)(ap1 + k0); a[2] = *(const h16x8*)(ap2 + k0); a[3] = *(const h16x8*)(ap3 + k0);
#pragma unroll
        for (int n = 0; n < 4; ++n) b[n] = *(const h16x8*)(bp + (size_t)n * 16 * K + k0);
#pragma unroll
        for (int m = 0; m < 4; ++m)
#pragma unroll
            for (int n = 0; n < 4; ++n) acc[m][n] = __builtin_amdgcn_mfma_f32_16x16x32_f16(b[n], a[m], acc[m][n], 0, 0, 0);
    }
#pragma unroll
    for (int m = 0; m < 4; ++m)
#pragma unroll
        for (int n = 0; n < 4; ++n) epi(m * 16 + fr, n * 16 + fq * 4, acc[m][n]);
}

template <class Src>
__device__ __forceinline__ void transpose_item(const Src src, int K, h16* WT, int nblk, int item, float* scr, int lane) {
    const int kb = item / nblk, nb = item % nblk, k0 = 64 * kb, n0 = 32 * nb;
#pragma unroll 8
    for (int i = 0; i < 32; ++i) { const int kk = 2 * i + (lane >> 5); scr[kk * 33 + (lane & 31)] = src(k0 + kk, n0 + (lane & 31)); }
    __builtin_amdgcn_s_waitcnt(0xC07F); __builtin_amdgcn_wave_barrier();
    const int c = lane & 7;
#pragma unroll
    for (int j = 0; j < 4; ++j) { const int n = (lane >> 3) + 8 * j; const float* s = scr + (8 * c) * 33 + n;
        u32x4 o; o.x = pk2(s[0 * 33], s[1 * 33]); o.y = pk2(s[2 * 33], s[3 * 33]); o.z = pk2(s[4 * 33], s[5 * 33]); o.w = pk2(s[6 * 33], s[7 * 33]);
        *(u32x4*)(WT + (size_t)(n0 + n) * K + k0 + 8 * c) = o; }
    __builtin_amdgcn_s_waitcnt(0xC07F); __builtin_amdgcn_wave_barrier();
}
__device__ __forceinline__ int win_src_col(int n) {
    if (n < O_V) { const int p = n & 63; return (n & ~63) + (p >> 1) + 32 * (p & 1); }
    if (n < O_G) return n;
    const int q = n - O_G; return O_G + (q & 1) * DM + (q >> 1);
}

__device__ __forceinline__ void ph0_prologue(const Params& P, float* lds) {
    const int tid = threadIdx.x, lane = tid & 63, wave = tid >> 6, nw = blockDim.x >> 6;
    const int gw = blockIdx.x * nw + wave, NGW = gridDim.x * nw;
    const int gt = blockIdx.x * blockDim.x + tid, NGT = gridDim.x * blockDim.x;
    unsigned char* ws = P.ws;
    float* rope = (float*)(ws + WS_ROPE);
    for (int it = gt; it < TT * 32; it += NGT) {
        const int t = it >> 5, i = it & 31;
        const float inv = 1.0f / powf(10000.0f, (float)(2 * i) / 64.0f);
        const float ang = (float)t * inv;
        rope[2 * it] = (float)cos((double)ang); rope[2 * it + 1] = (float)sin((double)ang);
    }
    if (gt == 0) {
        float s1 = 0.f, s2 = 0.f;
        for (int i = 0; i < HD; ++i) { s1 += P.lq1[i] * P.lk1[i]; s2 += P.lq2[i] * P.lk2[i]; }
        *(float*)(ws + WS_LAM) = expf(s1) - expf(s2) + LAMBDA_INIT;
    }
    float* scr = lds + wave * (64 * 33);
    {
        h16* WinT = (h16*)(ws + WS_WIN); const float* w = P.w_in;
        auto src = [w](int k, int n) { return w[(size_t)k * IN_W + win_src_col(n)]; };
        for (int it = gw; it < (DM / 64) * (IN_W / 32); it += NGW) transpose_item(src, DM, WinT, IN_W / 32, it, scr, lane);
    }
    {
        h16* WaT = (h16*)(ws + WS_WA); const float* w = P.w_attn_br;
        auto src = [w](int k, int n) { return w[(size_t)k * DM + n]; };
        for (int it = gw; it < (DM / 64) * (DM / 32); it += NGW) transpose_item(src, DM, WaT, DM / 32, it, scr, lane);
    }
    {
        h16* WoT = (h16*)(ws + WS_WOUT); const float* w = P.w_out;
        auto src = [w](int k, int n) { return w[(size_t)k * DM + n]; };
        for (int it = gw; it < (DM / 64) * (DM / 32); it += NGW) transpose_item(src, DM, WoT, DM / 32, it, scr, lane);
    }
    {
        h16* WeT = (h16*)(ws + WS_WEFF);
        for (int it = gw; it < 4 * 16 * 16; it += NGW) {
            const int nb = it & 15, c8 = (it >> 4) & 15, g = it >> 8, n = nb * 64 + lane;
            float acc[8];
#pragma unroll
            for (int j = 0; j < 8; ++j) acc[j] = 0.f;
            for (int d = 0; d < 128; ++d) {
                const float wv = P.w_pool_br[(size_t)(g * 128 + d) * DM + n] * P.pool_scale[g * 128 + d];
#pragma unroll
                for (int j = 0; j < 8; ++j) acc[j] += P.pool_w[((size_t)g * 128 + c8 * 8 + j) * 128 + d] * wv;
            }
            u32x4 o; o.x = pk2(acc[0], acc[1]); o.y = pk2(acc[2], acc[3]); o.z = pk2(acc[4], acc[5]); o.w = pk2(acc[6], acc[7]);
            *(u32x4*)(WeT + (size_t)n * PW + g * 128 + c8 * 8) = o;
        }
    }
    {
        h16* HN = (h16*)(ws + WS_RA);
        for (int r = gw; r < MROWS; r += NGW) {
            u32x2* o = (u32x2*)(HN + (size_t)r * DM) + lane;
            if (r >= NX + NMETA) {
#pragma unroll
                for (int j = 0; j < 4; ++j) o[64 * j] = (u32x2){0u, 0u};
                continue;
            }
            const float* src = r < NX ? P.x + (size_t)r * DM : P.meta + (size_t)(r - NX) * DM;
            const f32x4* xr = (const f32x4*)src + lane;
            f32x4 v[4]; float s = 0.f;
#pragma unroll
            for (int j = 0; j < 4; ++j) { v[j] = xr[64 * j]; s += (v[j].x * v[j].x + v[j].y * v[j].y) + (v[j].z * v[j].z + v[j].w * v[j].w); }
            const float rs = rsqrtf(wave_sum(s) * (1.f / DM) + EPS);
#pragma unroll
            for (int j = 0; j < 4; ++j) { const f32x4 g = ((const f32x4*)P.norm1_g)[lane + 64 * j];
                o[64 * j] = (u32x2){pk2(v[j].x * rs * g.x, v[j].y * rs * g.y), pk2(v[j].z * rs * g.z, v[j].w * rs * g.w)}; }
        }
    }
}

struct EpiZ {
    const float* rope; const float* b_gate; h16 *Q, *K, *V, *U, *G0, *R;
    __device__ __forceinline__ void operator()(int row, int col, f32x4 v) const {
        if (col < O_V) {
            const int t = pos_of_row(row); const int i0 = (col & 63) >> 1;
            const f32x4 cs = *(const f32x4*)(rope + ((size_t)t * 32 + i0) * 2);
            float o0 = v.x * cs.x - v.y * cs.y, o1 = v.y * cs.x + v.x * cs.y, o2 = v.z * cs.z - v.w * cs.w, o3 = v.w * cs.z + v.z * cs.w;
            if (col < O_K) { o0 *= C2; o1 *= C2; o2 *= C2; o3 *= C2; *(u32x2*)(Q + (size_t)row * DM + col) = (u32x2){pk2(o0, o1), pk2(o2, o3)}; }
            else *(u32x2*)(K + (size_t)row * DM + (col - O_K)) = (u32x2){pk2(o0, o1), pk2(o2, o3)};
        } else if (col < O_P) { *(u32x2*)(V + (size_t)row * DM + (col - O_V)) = (u32x2){pk2(v.x, v.y), pk2(v.z, v.w)};
        } else if (col < O_G) { *(u32x2*)(U + (size_t)row * PW + (col - O_P)) = (u32x2){pk2(v.x, v.y), pk2(v.z, v.w)};
        } else if (row < NX) {
            const int j = (col - O_G) >> 1;
            const float a0 = v.x + b_gate[j], a1 = v.y + b_gate[DM + j], c0 = v.z + b_gate[j + 1], c1 = v.w + b_gate[DM + j + 1];
            const float ea0 = __expf(-a0), ea1 = __expf(-a1), ec0 = __expf(-c0), ec1 = __expf(-c1);
            const float g0a = 1.f / (1.f + ea0), g0c = 1.f / (1.f + ec0);
            const float ra = (1.f + ea0) / (1.f + ea1), rc = (1.f + ec0) / (1.f + ec1);
            *(unsigned*)(G0 + (size_t)row * DM + j) = pk2(g0a, g0c);
            *(unsigned*)(R + (size_t)row * DM + j) = pk2(ra, rc);
        }
    }
};
__device__ __forceinline__ void ph1_zgemm(const Params& P) {
    const int tid = threadIdx.x, lane = tid & 63, wave = tid >> 6, nw = blockDim.x >> 6;
    const int gw = blockIdx.x * nw + wave, NGW = gridDim.x * nw;
    unsigned char* ws = P.ws;
    const h16* HN = (const h16*)(ws + WS_RA); const h16* WinT = (const h16*)(ws + WS_WIN);
    EpiZ E{(const float*)(ws + WS_ROPE), P.b_gate, (h16*)(ws + WS_RB), (h16*)(ws + WS_RC), (h16*)(ws + WS_RD), (h16*)(ws + WS_RE), (h16*)(ws + WS_RG), (h16*)(ws + WS_RG + 32 * MiB)};
    constexpr int NT_N = IN_W / 64, NT_M = MROWS / 64;
    for (int it = gw; it < NT_M * NT_N; it += NGW) {
        const int mt = it / NT_N, nt = it % NT_N;
        auto rowptr = [HN, mt](int r) { return HN + (size_t)(mt * 64 + r) * DM; };
        auto epi = [&E, mt, nt](int r, int c, f32x4 v) { E(mt * 64 + r, nt * 64 + c, v); };
        wgemm64(rowptr, WinT + (size_t)nt * 64 * DM, DM, lane, epi);
    }
}

__device__ __forceinline__ void ph2_attn(const Params& P) {
    const int tid = threadIdx.x, lane = tid & 63, wave = tid >> 6, nw = blockDim.x >> 6;
    const int gw = blockIdx.x * nw + wave, NGW = gridDim.x * nw;
    unsigned char* ws = P.ws;
    const h16* Q = (const h16*)(ws + WS_RB); const h16* Kb = (const h16*)(ws + WS_RC); const h16* Vb = (const h16*)(ws + WS_RD); h16* A = (h16*)(ws + WS_RB);
    const float lam = *(const float*)(ws + WS_LAM);
    for (int task = gw; task < NX * NH; task += NGW) {
        const int r = __builtin_amdgcn_readfirstlane(task >> 3), h = __builtin_amdgcn_readfirstlane(task & 7);
        const int b = r >> 11, i = r & (SEQ - 1), t = NMETA + i;
        h16x2 qv[64];
        { const h16x8* qp = (const h16x8*)(Q + (size_t)r * DM + h * 128);
#pragma unroll
          for (int j = 0; j < 16; ++j) { const h16x8 q8 = qp[j]; qv[4 * j] = (h16x2){q8[0], q8[1]}; qv[4 * j + 1] = (h16x2){q8[2], q8[3]}; qv[4 * j + 2] = (h16x2){q8[4], q8[5]}; qv[4 * j + 3] = (h16x2){q8[6], q8[7]}; } }
        float m0 = -1e30f, m1 = -1e30f, l0 = 0.f, l1 = 0.f; f32x2 O0 = {0.f, 0.f}, O1 = {0.f, 0.f};
        const int ntile = (t + 64) >> 6;
        for (int kt = 0; kt < ntile; ++kt) {
            const int p = kt * 64 + lane; const bool valid = p <= t; const int pc = valid ? p : t;
            const h16* krow = Kb + (size_t)row_of_pos(b, pc) * DM + h * 128;
            float s0 = 0.f, s1 = 0.f;
#pragma unroll
            for (int j = 0; j < 8; ++j) { const h16x8 k8 = ((const h16x8*)krow)[j];
                s0 = __builtin_amdgcn_fdot2((h16x2){k8[0], k8[1]}, qv[4 * j], s0, false); s0 = __builtin_amdgcn_fdot2((h16x2){k8[2], k8[3]}, qv[4 * j + 1], s0, false);
                s0 = __builtin_amdgcn_fdot2((h16x2){k8[4], k8[5]}, qv[4 * j + 2], s0, false); s0 = __builtin_amdgcn_fdot2((h16x2){k8[6], k8[7]}, qv[4 * j + 3], s0, false); }
#pragma unroll
            for (int j = 8; j < 16; ++j) { const h16x8 k8 = ((const h16x8*)krow)[j];
                s1 = __builtin_amdgcn_fdot2((h16x2){k8[0], k8[1]}, qv[4 * j], s1, false); s1 = __builtin_amdgcn_fdot2((h16x2){k8[2], k8[3]}, qv[4 * j + 1], s1, false);
                s1 = __builtin_amdgcn_fdot2((h16x2){k8[4], k8[5]}, qv[4 * j + 2], s1, false); s1 = __builtin_amdgcn_fdot2((h16x2){k8[6], k8[7]}, qv[4 * j + 3], s1, false); }
            if (!valid) { s0 = -1e30f; s1 = -1e30f; }
            const float mn0 = fmaxf(m0, wave_max(s0)), mn1 = fmaxf(m1, wave_max(s1));
            const float al0 = exp2f(m0 - mn0), al1 = exp2f(m1 - mn1);
            const float p0 = valid ? exp2f(s0 - mn0) : 0.f, p1 = valid ? exp2f(s1 - mn1) : 0.f;
            l0 = l0 * al0 + wave_sum(p0); l1 = l1 * al1 + wave_sum(p1); m0 = mn0; m1 = mn1;
            O0 *= al0; O1 *= al1;
            const int nk = min(64, t + 1 - kt * 64);
            for (int j = 0; j < nk; ++j) {
                const float a0 = __int_as_float(__builtin_amdgcn_readlane(__float_as_int(p0), j)); const float a1 = __int_as_float(__builtin_amdgcn_readlane(__float_as_int(p1), j));
                const h16x2 v2 = *(const h16x2*)(Vb + (size_t)row_of_pos(b, kt * 64 + j) * DM + h * 128 + 2 * lane);
                const float vx = (float)v2[0], vy = (float)v2[1];
                O0.x += a0 * vx; O0.y += a0 * vy; O1.x += a1 * vx; O1.y += a1 * vy;
            }
        }
        const float il0 = 1.f / l0, il1 = lam / l1;
        const float ox = O0.x * il0 - O1.x * il1, oy = O0.y * il0 - O1.y * il1;
        const float ss = wave_sum(ox * ox + oy * oy);
        const float rs = rsqrtf(ss * (1.f / VD) + EPS) * (1.f - LAMBDA_INIT);
        *(unsigned*)(A + (size_t)r * DM + h * 128 + 2 * lane) = pk2(ox * rs * P.subln_g[2 * lane], oy * rs * P.subln_g[2 * lane + 1]);
    }
}
__device__ __forceinline__ void ph2_pool(const Params& P) {
    const int gt = blockIdx.x * blockDim.x + threadIdx.x, NGT = gridDim.x * blockDim.x;
    unsigned char* ws = P.ws;
    const h16* U = (const h16*)(ws + WS_RE); h16* Y = (h16*)(ws + WS_RF);
    for (int it = gt; it < NX * (PW / 2); it += NGT) {
        const int r = it >> 8, c = (it & 255) * 2, g = c >> 7, w = 2 << g;
        const int b = r >> 11, t = NMETA + (r & (SEQ - 1));
        float sx = 0.f, sy = 0.f;
        for (int p = t - w + 1; p <= t; ++p) { const h16x2 u2 = *(const h16x2*)(U + (size_t)row_of_pos(b, p) * PW + c); sx += (float)u2[0]; sy += (float)u2[1]; }
        const h16x2 u0 = *(const h16x2*)(U + (size_t)r * PW + c);
        const float iw = 1.f / (float)w;
        *(unsigned*)(Y + (size_t)r * PW + c) = pk2(sx * iw - (float)u0[0], sy * iw - (float)u0[1]);
    }
}

__device__ __forceinline__ void ph2b_moew(const Params& P, float* lds) {
    const int tid = threadIdx.x, lane = tid & 63, wave = tid >> 6, nw = blockDim.x >> 6;
    const int gw = blockIdx.x * nw + wave, NGW = gridDim.x * nw;
    unsigned char* ws = P.ws; float* scr = lds + wave * (64 * 33);
    h16* WguT = (h16*)(ws + WS_RD); h16* WdnT = (h16*)(ws + WS_RC);
    constexpr int I_GU = (DM / 64) * (2 * DE / 32), I_DN = (DE / 64) * (DM / 32);
    for (int it = gw; it < NE * I_GU; it += NGW) {
        const int e = it / I_GU, r = it % I_GU; const float* wg = P.w_eg + (size_t)e * DM * DE; const float* wu = P.w_eu + (size_t)e * DM * DE;
        const long long du = (const char*)wu - (const char*)wg;
        auto src = [wg, du](int k, int n) { return *(const float*)((const char*)(wg + (size_t)k * DE + (n >> 1)) + ((n & 1) ? du : 0ll)); };
        transpose_item(src, DM, WguT + (size_t)e * (2 * DE) * DM, 2 * DE / 32, r, scr, lane);
    }
    for (int it = gw; it < NE * I_DN; it += NGW) {
        const int e = it / I_DN, r = it % I_DN; const float* wd = P.w_ed + (size_t)e * DE * DM;
        auto src = [wd](int k, int n) { return wd[(size_t)k * DM + n]; };
        transpose_item(src, DE, WdnT + (size_t)e * DM * DE, DM / 32, r, scr, lane);
    }
}

template <int PASS>
__device__ __forceinline__ void ph3a_mixed(const Params& P) {
    const int tid = threadIdx.x, lane = tid & 63, wave = tid >> 6, nw = blockDim.x >> 6;
    const int gw = blockIdx.x * nw + wave, NGW = gridDim.x * nw;
    unsigned char* ws = P.ws;
    const h16* A = (const h16*)(ws + WS_RB); const h16* Y = (const h16*)(ws + WS_RF);
    const h16* WaT = (const h16*)(ws + WS_WA); const h16* WeT = (const h16*)(ws + WS_WEFF);
    const h16* G0 = (const h16*)(ws + WS_RG); const h16* R = (const h16*)(ws + WS_RG + 32 * MiB); h16* MX = (h16*)(ws + WS_RA);
    constexpr int NT_N = DM / 64, NT_M = NX / 64;
    for (int it = gw; it < NT_M * NT_N; it += NGW) {
        const int mt = it / NT_N, nt = it % NT_N;
        if (PASS == 0) {
            auto rowptr = [Y, mt](int r) { return Y + (size_t)(mt * 64 + r) * PW; };
            auto epi = [=](int r, int c, f32x4 v) { const size_t o = (size_t)(mt * 64 + r) * DM + nt * 64 + c;
                const h16x4 g = *(const h16x4*)(G0 + o), q = *(const h16x4*)(R + o);
                *(u32x2*)(MX + o) = (u32x2){pk2(v.x * (float)g[0] * (float)q[0], v.y * (float)g[1] * (float)q[1]), pk2(v.z * (float)g[2] * (float)q[2], v.w * (float)g[3] * (float)q[3])}; };
            wgemm64(rowptr, WeT + (size_t)nt * 64 * PW, PW, lane, epi);
        } else {
            auto rowptr = [A, mt](int r) { return A + (size_t)(mt * 64 + r) * DM; };
            auto epi = [=](int r, int c, f32x4 v) { const size_t o = (size_t)(mt * 64 + r) * DM + nt * 64 + c;
                const h16x4 g = *(const h16x4*)(G0 + o), t1 = *(const h16x4*)(MX + o);
                *(u32x2*)(MX + o) = (u32x2){pk2(v.x * (float)g[0] + (float)t1[0], v.y * (float)g[1] + (float)t1[1]), pk2(v.z * (float)g[2] + (float)t1[2], v.w * (float)g[3] + (float)t1[3])}; };
            wgemm64(rowptr, WaT + (size_t)nt * 64 * DM, DM, lane, epi);
        }
    }
}
__device__ __forceinline__ void ph3b_h1(const Params& P) {
    const int tid = threadIdx.x, lane = tid & 63, wave = tid >> 6, nw = blockDim.x >> 6;
    const int gw = blockIdx.x * nw + wave, NGW = gridDim.x * nw;
    unsigned char* ws = P.ws;
    const h16* MX = (const h16*)(ws + WS_RA); const h16* WoT = (const h16*)(ws + WS_WOUT); const float* x = P.x; float* out = P.out;
    constexpr int NT_N = DM / 64, NT_M = NX / 64;
    for (int it = gw; it < NT_M * NT_N; it += NGW) {
        const int mt = it / NT_N, nt = it % NT_N;
        auto rowptr = [MX, mt](int r) { return MX + (size_t)(mt * 64 + r) * DM; };
        auto epi = [=](int r, int c, f32x4 v) { const size_t o = (size_t)(mt * 64 + r) * DM + nt * 64 + c; *(f32x4*)(out + o) = *(const f32x4*)(x + o) + v; };
        wgemm64(rowptr, WoT + (size_t)nt * 64 * DM, DM, lane, epi);
    }
}
__device__ __forceinline__ void ph3c_route(const Params& P) {
    const int tid = threadIdx.x, lane = tid & 63, wave = tid >> 6, nw = blockDim.x >> 6;
    const int gw = blockIdx.x * nw + wave, NGW = gridDim.x * nw;
    unsigned char* ws = P.ws;
    h16* HN2 = (h16*)(ws + WS_RB); unsigned* cnt = (unsigned*)(ws + WS_CTL) + CW_CNT; int* list = (int*)(ws + WS_LIST); float* tokw = (float*)(ws + WS_TOKW);
    for (int r = gw; r < NX; r += NGW) {
        const f32x4* hr = (const f32x4*)(P.out + (size_t)r * DM) + lane;
        f32x4 v[4]; float s = 0.f;
#pragma unroll
        for (int j = 0; j < 4; ++j) { v[j] = hr[64 * j]; s += (v[j].x * v[j].x + v[j].y * v[j].y) + (v[j].z * v[j].z + v[j].w * v[j].w); }
        const float rs = rsqrtf(wave_sum(s) * (1.f / DM) + EPS);
        float lg[20];
#pragma unroll
        for (int e = 0; e < 20; ++e) lg[e] = 0.f;
        u32x2* o = (u32x2*)(HN2 + (size_t)r * DM) + lane;
#pragma unroll
        for (int j = 0; j < 4; ++j) {
            const f32x4 g = ((const f32x4*)P.norm2_g)[lane + 64 * j];
            const f32x4 hn = {v[j].x * rs * g.x, v[j].y * rs * g.y, v[j].z * rs * g.z, v[j].w * rs * g.w};
            o[64 * j] = (u32x2){pk2(hn.x, hn.y), pk2(hn.z, hn.w)};
            const int k0 = (lane + 64 * j) * 4;
#pragma unroll
            for (int q = 0; q < 4; ++q) {
                const float hv = hn[q]; const f32x4 wg = *(const f32x4*)(P.w_rg + (size_t)(k0 + q) * 4);
                lg[0] += hv * wg.x; lg[1] += hv * wg.y; lg[2] += hv * wg.z; lg[3] += hv * wg.w;
#pragma unroll
                for (int e4 = 0; e4 < 4; ++e4) { const f32x4 we = *(const f32x4*)(P.w_re + (size_t)(k0 + q) * 16 + e4 * 4);
                    lg[4 + e4 * 4] += hv * we.x; lg[5 + e4 * 4] += hv * we.y; lg[6 + e4 * 4] += hv * we.z; lg[7 + e4 * 4] += hv * we.w; }
            }
        }
#pragma unroll
        for (int e = 0; e < 20; ++e) lg[e] = wave_sum(lg[e]);
        if (lane == 0) {
            float gl[4]; int gs = 0;
#pragma unroll
            for (int g = 0; g < 4; ++g) gl[g] = lg[g] + P.b_rg[g];
#pragma unroll
            for (int g = 1; g < 4; ++g) if (gl[g] > gl[gs]) gs = g;
            float den = 0.f;
#pragma unroll
            for (int g = 0; g < 4; ++g) den += expf(gl[g] - gl[gs]);
            const float pg = 1.f / den;
            float el[4];
#pragma unroll
            for (int q = 0; q < 4; ++q) { float a = 0.f;
#pragma unroll
                for (int g = 0; g < 4; ++g) a = (g == gs) ? lg[4 + g * 4 + q] : a;
                el[q] = a + P.b_re[gs * 4 + q]; }
            int i1 = 0;
#pragma unroll
            for (int q = 1; q < 4; ++q) if (el[q] > el[i1]) i1 = q;
            int i2 = (i1 == 0) ? 1 : 0;
#pragma unroll
            for (int q = 0; q < 4; ++q) if (q != i1 && el[q] > el[i2]) i2 = q;
            const float ed = expf(el[i2] - el[i1]);
            const float w1 = pg / (1.f + ed), w2 = pg * ed / (1.f + ed);
            const int e1 = gs * 4 + i1, e2 = gs * 4 + i2;
            const unsigned p1 = atomicAdd(cnt + e1, 1u), p2 = atomicAdd(cnt + e2, 1u);
            list[e1 * NX + p1] = r * 2; list[e2 * NX + p2] = r * 2 + 1;
            tokw[r * 2] = w1; tokw[r * 2 + 1] = w2;
        }
    }
}
__device__ __forceinline__ void ph4_moe1(const Params& P) {
    const int tid = threadIdx.x, lane = tid & 63, wave = tid >> 6, nw = blockDim.x >> 6;
    const int gw = blockIdx.x * nw + wave, NGW = gridDim.x * nw;
    unsigned char* ws = P.ws;
    const h16* HN2 = (const h16*)(ws + WS_RB); const h16* WguT = (const h16*)(ws + WS_RD); h16* ACT = (h16*)(ws + WS_RA);
    const unsigned* cnt = (const unsigned*)(ws + WS_CTL) + CW_CNT; const int* list = (const int*)(ws + WS_LIST);
    for (int it = gw; it < NE * 256 * 16; it += NGW) {
        const int e = it >> 12, rt = (it >> 4) & 255, ct = it & 15;
        const int n_e = (int)cnt[e]; if (rt * 64 >= n_e) continue;
        int off = 0; for (int q = 0; q < e; ++q) off += (int)cnt[q];
        const int* le = list + (size_t)e * NX;
        auto rowptr = [=](int r) { int idx = rt * 64 + r; idx = idx < n_e ? idx : n_e - 1; return HN2 + (size_t)(le[idx] >> 1) * DM; };
        auto epi = [=](int r, int c, f32x4 v) { const int idx = rt * 64 + r; if (idx >= n_e) return;
            const float a0 = v.x / (1.f + __expf(-v.x)) * v.y, a1 = v.z / (1.f + __expf(-v.z)) * v.w;
            *(unsigned*)(ACT + (size_t)(off + idx) * DE + ((ct * 64 + c) >> 1)) = pk2(a0, a1); };
        wgemm64(rowptr, WguT + ((size_t)e * (2 * DE) + ct * 64) * DM, DM, lane, epi);
    }
}
__device__ __forceinline__ void ph5_moe2(const Params& P) {
    const int tid = threadIdx.x, lane = tid & 63, wave = tid >> 6, nw = blockDim.x >> 6;
    const int gw = blockIdx.x * nw + wave, NGW = gridDim.x * nw;
    unsigned char* ws = P.ws;
    const h16* ACT = (const h16*)(ws + WS_RA); const h16* WdnT = (const h16*)(ws + WS_RC); h16* YE = (h16*)(ws + WS_RG);
    const unsigned* cnt = (const unsigned*)(ws + WS_CTL) + CW_CNT; const int* list = (const int*)(ws + WS_LIST); const float* tokw = (const float*)(ws + WS_TOKW);
    for (int it = gw; it < NE * 256 * 16; it += NGW) {
        const int e = it >> 12, rt = (it >> 4) & 255, ct = it & 15;
        const int n_e = (int)cnt[e]; if (rt * 64 >= n_e) continue;
        int off = 0; for (int q = 0; q < e; ++q) off += (int)cnt[q];
        const int* le = list + (size_t)e * NX;
        auto rowptr = [=](int r) { int idx = rt * 64 + r; idx = idx < n_e ? idx : n_e - 1; return ACT + (size_t)(off + idx) * DE; };
        auto epi = [=](int r, int c, f32x4 v) { const int idx = rt * 64 + r; if (idx >= n_e) return;
            const int ts = le[idx]; const float w = tokw[ts];
            *(u32x2*)(YE + (size_t)ts * DM + ct * 64 + c) = (u32x2){pk2(v.x * w, v.y * w), pk2(v.z * w, v.w * w)}; };
        wgemm64(rowptr, WdnT + ((size_t)e * DM + ct * 64) * DE, DE, lane, epi);
    }
}
__device__ __forceinline__ void ph6_final(const Params& P) {
    const int tid = threadIdx.x, lane = tid & 63, wave = tid >> 6, nw = blockDim.x >> 6;
    const int gw = blockIdx.x * nw + wave, NGW = gridDim.x * nw;
    const h16* YE = (const h16*)(P.ws + WS_RG);
    for (int r = gw; r < NX; r += NGW) {
        f32x4* hr = (f32x4*)(P.out + (size_t)r * DM) + lane;
        const h16x4* y0 = (const h16x4*)(YE + (size_t)(2 * r) * DM) + lane; const h16x4* y1 = (const h16x4*)(YE + (size_t)(2 * r + 1) * DM) + lane;
        f32x4 v[4]; float s = 0.f;
#pragma unroll
        for (int j = 0; j < 4; ++j) { const h16x4 a = y0[64 * j], b = y1[64 * j]; v[j] = hr[64 * j];
            v[j].x += (float)a[0] + (float)b[0]; v[j].y += (float)a[1] + (float)b[1]; v[j].z += (float)a[2] + (float)b[2]; v[j].w += (float)a[3] + (float)b[3];
            s += (v[j].x * v[j].x + v[j].y * v[j].y) + (v[j].z * v[j].z + v[j].w * v[j].w); }
        const float rs = rsqrtf(wave_sum(s) * (1.f / DM) + EPS);
#pragma unroll
        for (int j = 0; j < 4; ++j) { const f32x4 g = ((const f32x4*)P.final_g)[lane + 64 * j]; hr[64 * j] = (f32x4){v[j].x * rs * g.x, v[j].y * rs * g.y, v[j].z * rs * g.z, v[j].w * rs * g.w}; }
    }
}

template <int PH>
__global__ void __launch_bounds__(256) k_phase(Params P) {
    extern __shared__ __attribute__((aligned(16))) float lds[];
    if (PH == 0) ph0_prologue(P, lds);
    if (PH == 1) ph1_zgemm(P);
    if (PH == 2) ph2_attn(P);
    if (PH == 3) ph2_pool(P);
    if (PH == 4) ph2b_moew(P, lds);
    if (PH == 5) ph3a_mixed<0>(P);
    if (PH == 6) ph3a_mixed<1>(P);
    if (PH == 7) ph3b_h1(P);
    if (PH == 8) ph3c_route(P);
    if (PH == 9) ph4_moe1(P);
    if (PH == 10) ph5_moe2(P);
    if (PH == 11) ph6_final(P);
}

extern "C" void kernel_launch(void* const* d_in, const int* in_sizes, int n_in, void* d_out, int out_size, void* d_ws, size_t ws_size, hipStream_t stream) {
    if (n_in != 24 || in_sizes[0] != NX * DM || out_size != NX * DM || ws_size < WS_END) {
        fprintf(stderr, "kernel_launch: unexpected shapes (n_in %d, in0 %d, out %d, ws %zu); nothing launched\n", n_in, n_in > 0 ? in_sizes[0] : -1, out_size, ws_size); return; }
    Params P{};
    const float** pp = (const float**)&P;
    for (int i = 0; i < 24; ++i) pp[i] = (const float*)d_in[i];
    P.out = (float*)d_out; P.ws = (unsigned char*)d_ws;
    (void)hipMemsetAsync((char*)d_ws + WS_CTL, 0, CTL_BYTES, stream);
    const int G = 2048, LDSB = 4 * 64 * 33 * 4;
    hipLaunchKernelGGL(k_phase<0>, dim3(G), dim3(256), LDSB, stream, P);
    hipLaunchKernelGGL(k_phase<1>, dim3(G), dim3(256), 0, stream, P);
    hipLaunchKernelGGL(k_phase<2>, dim3(G), dim3(256), 0, stream, P);
    hipLaunchKernelGGL(k_phase<3>, dim3(G), dim3(256), 0, stream, P);
    hipLaunchKernelGGL(k_phase<4>, dim3(G), dim3(256), LDSB, stream, P);
    hipLaunchKernelGGL(k_phase<5>, dim3(G), dim3(256), 0, stream, P);
    hipLaunchKernelGGL(k_phase<6>, dim3(G), dim3(256), 0, stream, P);
    hipLaunchKernelGGL(k_phase<7>, dim3(G), dim3(256), 0, stream, P);
    hipLaunchKernelGGL(k_phase<8>, dim3(G), dim3(256), 0, stream, P);
    hipLaunchKernelGGL(k_phase<9>, dim3(G), dim3(256), 0, stream, P);
    hipLaunchKernelGGL(k_phase<10>, dim3(G), dim3(256), 0, stream, P);
    hipLaunchKernelGGL(k_phase<11>, dim3(G), dim3(256), 0, stream, P);
}
```

```cpp
#include <hip/hip_runtime.h>
#include <hip/hip_cooperative_groups.h>
#include <cstdio>
#include <cstdint>

typedef _Float16 h16;
typedef _Float16 h16x2 __attribute__((ext_vector_type(2)));
typedef _Float16 h16x4 __attribute__((ext_vector_type(4)));
typedef _Float16 h16x8 __attribute__((ext_vector_type(8)));
typedef float f32x2 __attribute__((ext_vector_type(2)));
typedef float f32x4 __attribute__((ext_vector_type(4)));
typedef unsigned u32x2 __attribute__((ext_vector_type(2)));
typedef unsigned u32x4 __attribute__((ext_vector_type(4)));

constexpr int NB = 8, SEQ = 2048, NMETA = 16, TT = SEQ + NMETA, DM = 1024;
constexpr int NX = NB * SEQ;
constexpr int MROWS = 16640;
constexpr int NH = 8, HD = 64, VD = 128;
constexpr int IN_W = 5632, O_K = 1024, O_V = 2048, O_P = 3072, O_G = 3584, PW = 512;
constexpr int NE = 16, DE = 512;
constexpr float EPS = 1e-6f;
constexpr float C2 = 0.125f * 1.4426950408889634f;
constexpr float LAMBDA_INIT = 0.2f;

constexpr size_t MiB = 1u << 20;
constexpr size_t WS_CTL = 0, CTL_BYTES = 1 * MiB;
constexpr size_t WS_ROPE = 1 * MiB;
constexpr size_t WS_LAM = 1 * MiB + 768 * 1024;
constexpr size_t WS_TOKW = 2 * MiB;
constexpr size_t WS_LIST = 3 * MiB;
constexpr size_t WS_WIN = 4 * MiB;
constexpr size_t WS_WA = 15 * MiB;
constexpr size_t WS_WEFF = 17 * MiB;
constexpr size_t WS_WOUT = 18 * MiB;
constexpr size_t WS_RA = 20 * MiB;
constexpr size_t WS_RB = WS_RA + 33 * MiB - MiB / 2;
constexpr size_t WS_RC = WS_RB + 33 * MiB - MiB / 2;
constexpr size_t WS_RD = WS_RC + 33 * MiB - MiB / 2;
constexpr size_t WS_RE = WS_RD + 33 * MiB - MiB / 2;
constexpr size_t WS_RF = WS_RE + 16 * MiB + MiB / 4;
constexpr size_t WS_RG = WS_RF + 16 * MiB;
constexpr size_t WS_END = WS_RG + 64 * MiB;
static_assert(WS_END <= 256 * MiB, "workspace map");
constexpr int CW_CNT = 64;

struct Params {
    const float *x, *meta, *norm1_g, *w_in, *b_gate, *lq1, *lk1, *lq2, *lk2, *subln_g, *pool_w, *pool_scale, *w_attn_br, *w_pool_br, *w_out, *norm2_g,
                *w_rg, *b_rg, *w_re, *b_re, *w_eg, *w_eu, *w_ed, *final_g;
    float* out; unsigned char* ws;
};

__device__ __forceinline__ unsigned pk2(float a, float b) { f32x2 v = {a, b}; h16x2 h = __builtin_convertvector(v, h16x2); return __builtin_bit_cast(unsigned, h); }
__device__ __forceinline__ float wave_sum(float v) {
#pragma unroll
    for (int o = 1; o < 64; o <<= 1) v += __shfl_xor(v, o);
    return v;
}
__device__ __forceinline__ float wave_max(float v) {
#pragma unroll
    for (int o = 1; o < 64; o <<= 1) v = fmaxf(v, __shfl_xor(v, o));
    return v;
}
__device__ __forceinline__ int pos_of_row(int r) { return r < NX ? NMETA + (r & (SEQ - 1)) : r - NX; }
__device__ __forceinline__ int row_of_pos(int b, int p) { return p < NMETA ? NX + p : b * SEQ + p - NMETA; }

template <class RowPtr, class Epi>
__device__ __forceinline__ void wgemm64(const RowPtr rowptr, const h16* Bt_tile, int K, int lane, const Epi epi) {
    const int fr = lane & 15, fq = lane >> 4;
    const h16* ap0 = rowptr(fr) + fq * 8; const h16* ap1 = rowptr(16 + fr) + fq * 8; const h16* ap2 = rowptr(32 + fr) + fq * 8; const h16* ap3 = rowptr(48 + fr) + fq * 8;
    const h16* bp = Bt_tile + (size_t)fr * K + fq * 8;
    f32x4 acc[4][4];
#pragma unroll
    for (int m = 0; m < 4; ++m)
#pragma unroll
        for (int n = 0; n < 4; ++n) acc[m][n] = (f32x4){0.f, 0.f, 0.f, 0.f};
#pragma unroll 2
    for (int k0 = 0; k0 < K; k0 += 32) {
        h16x8 a[4], b[4];
        a[0] = *(const h16x8*)(ap0 + k0); a[1] = *(const h16x8*)(ap1 + k0); a[2] = *(const h16x8*)(ap2 + k0); a[3] = *(const h16x8*)(ap3 + k0);
#pragma unroll
        for (int n = 0; n < 4; ++n) b[n] = *(const h16x8*)(bp + (size_t)n * 16 * K + k0);
#pragma unroll
        for (int m = 0; m < 4; ++m)
#pragma unroll
            for (int n = 0; n < 4; ++n) acc[m][n] = __builtin_amdgcn_mfma_f32_16x16x32_f16(b[n], a[m], acc[m][n], 0, 0, 0);
    }
#pragma unroll
    for (int m = 0; m < 4; ++m)
#pragma unroll
        for (int n = 0; n < 4; ++n) epi(m * 16 + fr, n * 16 + fq * 4, acc[m][n]);
}

template <class Src>
__device__ __forceinline__ void transpose_item(const Src src, int K, h16* WT, int nblk, int item, float* scr, int lane) {
    const int kb = item / nblk, nb = item % nblk, k0 = 64 * kb, n0 = 32 * nb;
#pragma unroll 8
    for (int i = 0; i < 32; ++i) { const int kk = 2 * i + (lane >> 5); scr[kk * 33 + (lane & 31)] = src(k0 + kk, n0 + (lane & 31)); }
    __builtin_amdgcn_s_waitcnt(0xC07F); __builtin_amdgcn_wave_barrier();
    const int c = lane & 7;
#pragma unroll
    for (int j = 0; j < 4; ++j) { const int n = (lane >> 3) + 8 * j; const float* s = scr + (8 * c) * 33 + n;
        u32x4 o; o.x = pk2(s[0 * 33], s[1 * 33]); o.y = pk2(s[2 * 33], s[3 * 33]); o.z = pk2(s[4 * 33], s[5 * 33]); o.w = pk2(s[6 * 33], s[7 * 33]);
        *(u32x4*)(WT + (size_t)(n0 + n) * K + k0 + 8 * c) = o; }
    __builtin_amdgcn_s_waitcnt(0xC07F); __builtin_amdgcn_wave_barrier();
}
__device__ __forceinline__ int win_src_col(int n) {
    if (n < O_V) { const int p = n & 63; return (n & ~63) + (p >> 1) + 32 * (p & 1); }
    if (n < O_G) return n;
    const int q = n - O_G; return O_G + (q & 1) * DM + (q >> 1);
}

__device__ __forceinline__ void ph0_prologue(const Params& P, float* lds) {
    const int tid = threadIdx.x, lane = tid & 63, wave = tid >> 6, nw = blockDim.x >> 6;
    const int gw = blockIdx.x * nw + wave, NGW = gridDim.x * nw;
    const int gt = blockIdx.x * blockDim.x + tid, NGT = gridDim.x * blockDim.x;
    unsigned char* ws = P.ws;
    float* rope = (float*)(ws + WS_ROPE);
    for (int it = gt; it < TT * 32; it += NGT) {
        const int t = it >> 5, i = it & 31;
        const float inv = 1.0f / powf(10000.0f, (float)(2 * i) / 64.0f);
        const float ang = (float)t * inv;
        rope[2 * it] = (float)cos((double)ang); rope[2 * it + 1] = (float)sin((double)ang);
    }
    if (gt == 0) {
        float s1 = 0.f, s2 = 0.f;
        for (int i = 0; i < HD; ++i) { s1 += P.lq1[i] * P.lk1[i]; s2 += P.lq2[i] * P.lk2[i]; }
        *(float*)(ws + WS_LAM) = expf(s1) - expf(s2) + LAMBDA_INIT;
    }
    float* scr = lds + wave * (64 * 33);
    {
        h16* WinT = (h16*)(ws + WS_WIN); const float* w = P.w_in;
        auto src = [w](int k, int n) { return w[(size_t)k * IN_W + win_src_col(n)]; };
        for (int it = gw; it < (DM / 64) * (IN_W / 32); it += NGW) transpose_item(src, DM, WinT, IN_W / 32, it, scr, lane);
    }
    {
        h16* WaT = (h16*)(ws + WS_WA); const float* w = P.w_attn_br;
        auto src = [w](int k, int n) { return w[(size_t)k * DM + n]; };
        for (int it = gw; it < (DM / 64) * (DM / 32); it += NGW) transpose_item(src, DM, WaT, DM / 32, it, scr, lane);
    }
    {
        h16* WoT = (h16*)(ws + WS_WOUT); const float* w = P.w_out;
        auto src = [w](int k, int n) { return w[(size_t)k * DM + n]; };
        for (int it = gw; it < (DM / 64) * (DM / 32); it += NGW) transpose_item(src, DM, WoT, DM / 32, it, scr, lane);
    }
    {
        h16* WeT = (h16*)(ws + WS_WEFF);
        for (int it = gw; it < 4 * 16 * 16; it += NGW) {
            const int nb = it & 15, c8 = (it >> 4) & 15, g = it >> 8, n = nb * 64 + lane;
            float acc[8];
#pragma unroll
            for (int j = 0; j < 8; ++j) acc[j] = 0.f;
            for (int d = 0; d < 128; ++d) {
                const float wv = P.w_pool_br[(size_t)(g * 128 + d) * DM + n] * P.pool_scale[g * 128 + d];
#pragma unroll
                for (int j = 0; j < 8; ++j) acc[j] += P.pool_w[((size_t)g * 128 + c8 * 8 + j) * 128 + d] * wv;
            }
            u32x4 o; o.x = pk2(acc[0], acc[1]); o.y = pk2(acc[2], acc[3]); o.z = pk2(acc[4], acc[5]); o.w = pk2(acc[6], acc[7]);
            *(u32x4*)(WeT + (size_t)n * PW + g * 128 + c8 * 8) = o;
        }
    }
    {
        h16* HN = (h16*)(ws + WS_RA);
        for (int r = gw; r < MROWS; r += NGW) {
            u32x2* o = (u32x2*)(HN + (size_t)r * DM) + lane;
            if (r >= NX + NMETA) {
#pragma unroll
                for (int j = 0; j < 4; ++j) o[64 * j] = (u32x2){0u, 0u};
                continue;
            }
            const float* src = r < NX ? P.x + (size_t)r * DM : P.meta + (size_t)(r - NX) * DM;
            const f32x4* xr = (const f32x4*)src + lane;
            f32x4 v[4]; float s = 0.f;
#pragma unroll
            for (int j = 0; j < 4; ++j) { v[j] = xr[64 * j]; s += (v[j].x * v[j].x + v[j].y * v[j].y) + (v[j].z * v[j].z + v[j].w * v[j].w); }
            const float rs = rsqrtf(wave_sum(s) * (1.f / DM) + EPS);
#pragma unroll
            for (int j = 0; j < 4; ++j) { const f32x4 g = ((const f32x4*)P.norm1_g)[lane + 64 * j];
                o[64 * j] = (u32x2){pk2(v[j].x * rs * g.x, v[j].y * rs * g.y), pk2(v[j].z * rs * g.z, v[j].w * rs * g.w)}; }
        }
    }
}

struct EpiZ {
    const float* rope; const float* b_gate; h16 *Q, *K, *V, *U, *G0, *R;
    __device__ __forceinline__ void operator()(int row, int col, f32x4 v) const {
        if (col < O_V) {
            const int t = pos_of_row(row); const int i0 = (col & 63) >> 1;
            const f32x4 cs = *(const f32x4*)(rope + ((size_t)t * 32 + i0) * 2);
            float o0 = v.x * cs.x - v.y * cs.y, o1 = v.y * cs.x + v.x * cs.y, o2 = v.z * cs.z - v.w * cs.w, o3 = v.w * cs.z + v.z * cs.w;
            if (col < O_K) { o0 *= C2; o1 *= C2; o2 *= C2; o3 *= C2; *(u32x2*)(Q + (size_t)row * DM + col) = (u32x2){pk2(o0, o1), pk2(o2, o3)}; }
            else *(u32x2*)(K + (size_t)row * DM + (col - O_K)) = (u32x2){pk2(o0, o1), pk2(o2, o3)};
        } else if (col < O_P) { *(u32x2*)(V + (size_t)row * DM + (col - O_V)) = (u32x2){pk2(v.x, v.y), pk2(v.z, v.w)};
        } else if (col < O_G) { *(u32x2*)(U + (size_t)row * PW + (col - O_P)) = (u32x2){pk2(v.x, v.y), pk2(v.z, v.w)};
        } else if (row < NX) {
            const int j = (col - O_G) >> 1;
            const float a0 = v.x + b_gate[j], a1 = v.y + b_gate[DM + j], c0 = v.z + b_gate[j + 1], c1 = v.w + b_gate[DM + j + 1];
            const float ea0 = __expf(-a0), ea1 = __expf(-a1), ec0 = __expf(-c0), ec1 = __expf(-c1);
            const float g0a = 1.f / (1.f + ea0), g0c = 1.f / (1.f + ec0);
            const float ra = (1.f + ea0) / (1.f + ea1), rc = (1.f + ec0) / (1.f + ec1);
            *(unsigned*)(G0 + (size_t)row * DM + j) = pk2(g0a, g0c);
            *(unsigned*)(R + (size_t)row * DM + j) = pk2(ra, rc);
        }
    }
};
__device__ __forceinline__ void ph1_zgemm(const Params& P) {
    const int tid = threadIdx.x, lane = tid & 63, wave = tid >> 6, nw = blockDim.x >> 6;
    const int gw = blockIdx.x * nw + wave, NGW = gridDim.x * nw;
    unsigned char* ws = P.ws;
    const h16* HN = (const h16*)(ws + WS_RA); const h16* WinT = (const h16*)(ws + WS_WIN);
    EpiZ E{(const float*)(ws + WS_ROPE), P.b_gate, (h16*)(ws + WS_RB), (h16*)(ws + WS_RC), (h16*)(ws + WS_RD), (h16*)(ws + WS_RE), (h16*)(ws + WS_RG), (h16*)(ws + WS_RG + 32 * MiB)};
    constexpr int NT_N = IN_W / 64, NT_M = MROWS / 64;
    for (int it = gw; it < NT_M * NT_N; it += NGW) {
        const int mt = it / NT_N, nt = it % NT_N;
        auto rowptr = [HN, mt](int r) { return HN + (size_t)(mt * 64 + r) * DM; };
        auto epi = [&E, mt, nt](int r, int c, f32x4 v) { E(mt * 64 + r, nt * 64 + c, v); };
        wgemm64(rowptr, WinT + (size_t)nt * 64 * DM, DM, lane, epi);
    }
}

__device__ __forceinline__ void ph2_attn(const Params& P) {
    const int tid = threadIdx.x, lane = tid & 63, wave = tid >> 6, nw = blockDim.x >> 6;
    const int gw = blockIdx.x * nw + wave, NGW = gridDim.x * nw;
    unsigned char* ws = P.ws;
    const h16* Q = (const h16*)(ws + WS_RB); const h16* Kb = (const h16*)(ws + WS_RC); const h16* Vb = (const h16*)(ws + WS_RD); h16* A = (h16*)(ws + WS_RB);
    const float lam = *(const float*)(ws + WS_LAM);
    for (int task = gw; task < NX * NH; task += NGW) {
        const int r = __builtin_amdgcn_readfirstlane(task >> 3), h = __builtin_amdgcn_readfirstlane(task & 7);
        const int b = r >> 11, i = r & (SEQ - 1), t = NMETA + i;
        h16x2 qv[64];
        { const h16x8* qp = (const h16x8*)(Q + (size_t)r * DM + h * 128);
#pragma unroll
          for (int j = 0; j < 16; ++j) { const h16x8 q8 = qp[j]; qv[4 * j] = (h16x2){q8[0], q8[1]}; qv[4 * j + 1] = (h16x2){q8[2], q8[3]}; qv[4 * j + 2] = (h16x2){q8[4], q8[5]}; qv[4 * j + 3] = (h16x2){q8[6], q8[7]}; } }
        float m0 = -1e30f, m1 = -1e30f, l0 = 0.f, l1 = 0.f; f32x2 O0 = {0.f, 0.f}, O1 = {0.f, 0.f};
        const int ntile = (t + 64) >> 6;
        for (int kt = 0; kt < ntile; ++kt) {
            const int p = kt * 64 + lane; const bool valid = p <= t; const int pc = valid ? p : t;
            const h16* krow = Kb + (size_t)row_of_pos(b, pc) * DM + h * 128;
            float s0 = 0.f, s1 = 0.f;
#pragma unroll
            for (int j = 0; j < 8; ++j) { const h16x8 k8 = ((const h16x8*)krow)[j];
                s0 = __builtin_amdgcn_fdot2((h16x2){k8[0], k8[1]}, qv[4 * j], s0, false); s0 = __builtin_amdgcn_fdot2((h16x2){k8[2], k8[3]}, qv[4 * j + 1], s0, false);
                s0 = __builtin_amdgcn_fdot2((h16x2){k8[4], k8[5]}, qv[4 * j + 2], s0, false); s0 = __builtin_amdgcn_fdot2((h16x2){k8[6], k8[7]}, qv[4 * j + 3], s0, false); }
#pragma unroll
            for (int j = 8; j < 16; ++j) { const h16x8 k8 = ((const h16x8*)krow)[j];
                s1 = __builtin_amdgcn_fdot2((h16x2){k8[0], k8[1]}, qv[4 * j], s1, false); s1 = __builtin_amdgcn_fdot2((h16x2){k8[2], k8[3]}, qv[4 * j + 1], s1, false);
                s1 = __builtin_amdgcn_fdot2((h16x2){k8[4], k8[5]}, qv[4 * j + 2], s1, false); s1 = __builtin_amdgcn_fdot2((h16x2){k8[6], k8[7]}, qv[4 * j + 3], s1, false); }
            if (!valid) { s0 = -1e30f; s1 = -1e30f; }
            const float mn0 = fmaxf(m0, wave_max(s0)), mn1 = fmaxf(m1, wave_max(s1));
            const float al0 = exp2f(m0 - mn0), al1 = exp2f(m1 - mn1);
            const float p0 = valid ? exp2f(s0 - mn0) : 0.f, p1 = valid ? exp2f(s1 - mn1) : 0.f;
            l0 = l0 * al0 + wave_sum(p0); l1 = l1 * al1 + wave_sum(p1); m0 = mn0; m1 = mn1;
            O0 *= al0; O1 *= al1;
            const int nk = min(64, t + 1 - kt * 64);
            for (int j = 0; j < nk; ++j) {
                const float a0 = __int_as_float(__builtin_amdgcn_readlane(__float_as_int(p0), j)); const float a1 = __int_as_float(__builtin_amdgcn_readlane(__float_as_int(p1), j));
                const h16x2 v2 = *(const h16x2*)(Vb + (size_t)row_of_pos(b, kt * 64 + j) * DM + h * 128 + 2 * lane);
                const float vx = (float)v2[0], vy = (float)v2[1];
                O0.x += a0 * vx; O0.y += a0 * vy; O1.x += a1 * vx; O1.y += a1 * vy;
            }
        }
        const float il0 = 1.f / l0, il1 = lam / l1;
        const float ox = O0.x * il0 - O1.x * il1, oy = O0.y * il0 - O1.y * il1;
        const float ss = wave_sum(ox * ox + oy * oy);
        const float rs = rsqrtf(ss * (1.f / VD) + EPS) * (1.f - LAMBDA_INIT);
        *(unsigned*)(A + (size_t)r * DM + h * 128 + 2 * lane) = pk2(ox * rs * P.subln_g[2 * lane], oy * rs * P.subln_g[2 * lane + 1]);
    }
}
__device__ __forceinline__ void ph2_pool(const Params& P) {
    const int gt = blockIdx.x * blockDim.x + threadIdx.x, NGT = gridDim.x * blockDim.x;
    unsigned char* ws = P.ws;
    const h16* U = (const h16*)(ws + WS_RE); h16* Y = (h16*)(ws + WS_RF);
    for (int it = gt; it < NX * (PW / 2); it += NGT) {
        const int r = it >> 8, c = (it & 255) * 2, g = c >> 7, w = 2 << g;
        const int b = r >> 11, t = NMETA + (r & (SEQ - 1));
        float sx = 0.f, sy = 0.f;
        for (int p = t - w + 1; p <= t; ++p) { const h16x2 u2 = *(const h16x2*)(U + (size_t)row_of_pos(b, p) * PW + c); sx += (float)u2[0]; sy += (float)u2[1]; }
        const h16x2 u0 = *(const h16x2*)(U + (size_t)r * PW + c);
        const float iw = 1.f / (float)w;
        *(unsigned*)(Y + (size_t)r * PW + c) = pk2(sx * iw - (float)u0[0], sy * iw - (float)u0[1]);
    }
}

__device__ __forceinline__ void ph2b_moew(const Params& P, float* lds) {
    const int tid = threadIdx.x, lane = tid & 63, wave = tid >> 6, nw = blockDim.x >> 6;
    const int gw = blockIdx.x * nw + wave, NGW = gridDim.x * nw;
    unsigned char* ws = P.ws; float* scr = lds + wave * (64 * 33);
    h16* WguT = (h16*)(ws + WS_RD); h16* WdnT = (h16*)(ws + WS_RC);
    constexpr int I_GU = (DM / 64) * (2 * DE / 32), I_DN = (DE / 64) * (DM / 32);
    for (int it = gw; it < NE * I_GU; it += NGW) {
        const int e = it / I_GU, r = it % I_GU; const float* wg = P.w_eg + (size_t)e * DM * DE; const float* wu = P.w_eu + (size_t)e * DM * DE;
        const long long du = (const char*)wu - (const char*)wg;
        auto src = [wg, du](int k, int n) { return *(const float*)((const char*)(wg + (size_t)k * DE + (n >> 1)) + ((n & 1) ? du : 0ll)); };
        transpose_item(src, DM, WguT + (size_t)e * (2 * DE) * DM, 2 * DE / 32, r, scr, lane);
    }
    for (int it = gw; it < NE * I_DN; it += NGW) {
        const int e = it / I_DN, r = it % I_DN; const float* wd = P.w_ed + (size_t)e * DE * DM;
        auto src = [wd](int k, int n) { return wd[(size_t)k * DM + n]; };
        transpose_item(src, DE, WdnT + (size_t)e * DM * DE, DM / 32, r, scr, lane);
    }
}

template <int PASS>
__device__ __forceinline__ void ph3a_mixed(const Params& P) {
    const int tid = threadIdx.x, lane = tid & 63, wave = tid >> 6, nw = blockDim.x >> 6;
    const int gw = blockIdx.x * nw + wave, NGW = gridDim.x * nw;
    unsigned char* ws = P.ws;
    const h16* A = (const h16*)(ws + WS_RB); const h16* Y = (const h16*)(ws + WS_RF);
    const h16* WaT = (const h16*)(ws + WS_WA); const h16* WeT = (const h16*)(ws + WS_WEFF);
    const h16* G0 = (const h16*)(ws + WS_RG); const h16* R = (const h16*)(ws + WS_RG + 32 * MiB); h16* MX = (h16*)(ws + WS_RA);
    constexpr int NT_N = DM / 64, NT_M = NX / 64;
    for (int it = gw; it < NT_M * NT_N; it += NGW) {
        const int mt = it / NT_N, nt = it % NT_N;
        if (PASS == 0) {
            auto rowptr = [Y, mt](int r) { return Y + (size_t)(mt * 64 + r) * PW; };
            auto epi = [=](int r, int c, f32x4 v) { const size_t o = (size_t)(mt * 64 + r) * DM + nt * 64 + c;
                const h16x4 g = *(const h16x4*)(G0 + o), q = *(const h16x4*)(R + o);
                *(u32x2*)(MX + o) = (u32x2){pk2(v.x * (float)g[0] * (float)q[0], v.y * (float)g[1] * (float)q[1]), pk2(v.z * (float)g[2] * (float)q[2], v.w * (float)g[3] * (float)q[3])}; };
            wgemm64(rowptr, WeT + (size_t)nt * 64 * PW, PW, lane, epi);
        } else {
            auto rowptr = [A, mt](int r) { return A + (size_t)(mt * 64 + r) * DM; };
            auto epi = [=](int r, int c, f32x4 v) { const size_t o = (size_t)(mt * 64 + r) * DM + nt * 64 + c;
                const h16x4 g = *(const h16x4*)(G0 + o), t1 = *(const h16x4*)(MX + o);
                *(u32x2*)(MX + o) = (u32x2){pk2(v.x * (float)g[0] + (float)t1[0], v.y * (float)g[1] + (float)t1[1]), pk2(v.z * (float)g[2] + (float)t1[2], v.w * (float)g[3] + (float)t1[3])}; };
            wgemm64(rowptr, WaT + (size_t)nt * 64 * DM, DM, lane, epi);
        }
    }
}
__device__ __forceinline__ void ph3b_h1(const Params& P) {
    const int tid = threadIdx.x, lane = tid & 63, wave = tid >> 6, nw = blockDim.x >> 6;
    const int gw = blockIdx.x * nw + wave, NGW = gridDim.x * nw;
    unsigned char* ws = P.ws;
    const h16* MX = (const h16*)(ws + WS_RA); const h16* WoT = (const h16*)(ws + WS_WOUT); const float* x = P.x; float* out = P.out;
    constexpr int NT_N = DM / 64, NT_M = NX / 64;
    for (int it = gw; it < NT_M * NT_N; it += NGW) {
        const int mt = it / NT_N, nt = it % NT_N;
        auto rowptr = [MX, mt](int r) { return MX + (size_t)(mt * 64 + r) * DM; };
        auto epi = [=](int r, int c, f32x4 v) { const size_t o = (size_t)(mt * 64 + r) * DM + nt * 64 + c; *(f32x4*)(out + o) = *(const f32x4*)(x + o) + v; };
        wgemm64(rowptr, WoT + (size_t)nt * 64 * DM, DM, lane, epi);
    }
}
__device__ __forceinline__ void ph3c_route(const Params& P) {
    const int tid = threadIdx.x, lane = tid & 63, wave = tid >> 6, nw = blockDim.x >> 6;
    const int gw = blockIdx.x * nw + wave, NGW = gridDim.x * nw;
    unsigned char* ws = P.ws;
    h16* HN2 = (h16*)(ws + WS_RB); unsigned* cnt = (unsigned*)(ws + WS_CTL) + CW_CNT; int* list = (int*)(ws + WS_LIST); float* tokw = (float*)(ws + WS_TOKW);
    for (int r = gw; r < NX; r += NGW) {
        const f32x4* hr = (const f32x4*)(P.out + (size_t)r * DM) + lane;
        f32x4 v[4]; float s = 0.f;
#pragma unroll
        for (int j = 0; j < 4; ++j) { v[j] = hr[64 * j]; s += (v[j].x * v[j].x + v[j].y * v[j].y) + (v[j].z * v[j].z + v[j].w * v[j].w); }
        const float rs = rsqrtf(wave_sum(s) * (1.f / DM) + EPS);
        float lg[20];
#pragma unroll
        for (int e = 0; e < 20; ++e) lg[e] = 0.f;
        u32x2* o = (u32x2*)(HN2 + (size_t)r * DM) + lane;
#pragma unroll
        for (int j = 0; j < 4; ++j) {
            const f32x4 g = ((const f32x4*)P.norm2_g)[lane + 64 * j];
            const f32x4 hn = {v[j].x * rs * g.x, v[j].y * rs * g.y, v[j].z * rs * g.z, v[j].w * rs * g.w};
            o[64 * j] = (u32x2){pk2(hn.x, hn.y), pk2(hn.z, hn.w)};
            const int k0 = (lane + 64 * j) * 4;
#pragma unroll
            for (int q = 0; q < 4; ++q) {
                const float hv = hn[q]; const f32x4 wg = *(const f32x4*)(P.w_rg + (size_t)(k0 + q) * 4);
                lg[0] += hv * wg.x; lg[1] += hv * wg.y; lg[2] += hv * wg.z; lg[3] += hv * wg.w;
#pragma unroll
                for (int e4 = 0; e4 < 4; ++e4) { const f32x4 we = *(const f32x4*)(P.w_re + (size_t)(k0 + q) * 16 + e4 * 4);
                    lg[4 + e4 * 4] += hv * we.x; lg[5 + e4 * 4] += hv * we.y; lg[6 + e4 * 4] += hv * we.z; lg[7 + e4 * 4] += hv * we.w; }
            }
        }
#pragma unroll
        for (int e = 0; e < 20; ++e) lg[e] = wave_sum(lg[e]);
        if (lane == 0) {
            float gl[4]; int gs = 0;
#pragma unroll
            for (int g = 0; g < 4; ++g) gl[g] = lg[g] + P.b_rg[g];
#pragma unroll
            for (int g = 1; g < 4; ++g) if (gl[g] > gl[gs]) gs = g;
            float den = 0.f;
#pragma unroll
            for (int g = 0; g < 4; ++g) den += expf(gl[g] - gl[gs]);
            const float pg = 1.f / den;
            float el[4];
#pragma unroll
            for (int q = 0; q < 4; ++q) { float a = 0.f;
#pragma unroll
                for (int g = 0; g < 4; ++g) a = (g == gs) ? lg[4 + g * 4 + q] : a;
                el[q] = a + P.b_re[gs * 4 + q]; }
            int i1 = 0;
#pragma unroll
            for (int q = 1; q < 4; ++q) if (el[q] > el[i1]) i1 = q;
            int i2 = (i1 == 0) ? 1 : 0;
#pragma unroll
            for (int q = 0; q < 4; ++q) if (q != i1 && el[q] > el[i2]) i2 = q;
            const float ed = expf(el[i2] - el[i1]);
            const float w1 = pg / (1.f + ed), w2 = pg * ed / (1.f + ed);
            const int e1 = gs * 4 + i1, e2 = gs * 4 + i2;
            const unsigned p1 = atomicAdd(cnt + e1, 1u), p2 = atomicAdd(cnt + e2, 1u);
            list[e1 * NX + p1] = r * 2; list[e2 * NX + p2] = r * 2 + 1;
            tokw[r * 2] = w1; tokw[r * 2 + 1] = w2;
        }
    }
}
__device__ __forceinline__ void ph4_moe1(const Params& P) {
    const int tid = threadIdx.x, lane = tid & 63, wave = tid >> 6, nw = blockDim.x >> 6;
    const int gw = blockIdx.x * nw + wave, NGW = gridDim.x * nw;
    unsigned char* ws = P.ws;
    const h16* HN2 = (const h16*)(ws + WS_RB); const h16* WguT = (const h16*)(ws + WS_RD); h16* ACT = (h16*)(ws + WS_RA);
    const unsigned* cnt = (const unsigned*)(ws + WS_CTL) + CW_CNT; const int* list = (const int*)(ws + WS_LIST);
    for (int it = gw; it < NE * 256 * 16; it += NGW) {
        const int e = it >> 12, rt = (it >> 4) & 255, ct = it & 15;
        const int n_e = (int)cnt[e]; if (rt * 64 >= n_e) continue;
        int off = 0; for (int q = 0; q < e; ++q) off += (int)cnt[q];
        const int* le = list + (size_t)e * NX;
        auto rowptr = [=](int r) { int idx = rt * 64 + r; idx = idx < n_e ? idx : n_e - 1; return HN2 + (size_t)(le[idx] >> 1) * DM; };
        auto epi = [=](int r, int c, f32x4 v) { const int idx = rt * 64 + r; if (idx >= n_e) return;
            const float a0 = v.x / (1.f + __expf(-v.x)) * v.y, a1 = v.z / (1.f + __expf(-v.z)) * v.w;
            *(unsigned*)(ACT + (size_t)(off + idx) * DE + ((ct * 64 + c) >> 1)) = pk2(a0, a1); };
        wgemm64(rowptr, WguT + ((size_t)e * (2 * DE) + ct * 64) * DM, DM, lane, epi);
    }
}
__device__ __forceinline__ void ph5_moe2(const Params& P) {
    const int tid = threadIdx.x, lane = tid & 63, wave = tid >> 6, nw = blockDim.x >> 6;
    const int gw = blockIdx.x * nw + wave, NGW = gridDim.x * nw;
    unsigned char* ws = P.ws;
    const h16* ACT = (const h16*)(ws + WS_RA); const h16* WdnT = (const h16*)(ws + WS_RC); h16* YE = (h16*)(ws + WS_RG);
    const unsigned* cnt = (const unsigned*)(ws + WS_CTL) + CW_CNT; const int* list = (const int*)(ws + WS_LIST); const float* tokw = (const float*)(ws + WS_TOKW);
    for (int it = gw; it < NE * 256 * 16; it += NGW) {
        const int e = it >> 12, rt = (it >> 4) & 255, ct = it & 15;
        const int n_e = (int)cnt[e]; if (rt * 64 >= n_e) continue;
        int off = 0; for (int q = 0; q < e; ++q) off += (int)cnt[q];
        const int* le = list + (size_t)e * NX;
        auto rowptr = [=](int r) { int idx = rt * 64 + r; idx = idx < n_e ? idx : n_e - 1; return ACT + (size_t)(off + idx) * DE; };
        auto epi = [=](int r, int c, f32x4 v) { const int idx = rt * 64 + r; if (idx >= n_e) return;
            const int ts = le[idx]; const float w = tokw[ts];
            *(u32x2*)(YE + (size_t)ts * DM + ct * 64 + c) = (u32x2){pk2(v.x * w, v.y * w), pk2(v.z * w, v.w * w)}; };
        wgemm64(rowptr, WdnT + ((size_t)e * DM + ct * 64) * DE, DE, lane, epi);
    }
}
__device__ __forceinline__ void ph6_final(const Params& P) {
    const int tid = threadIdx.x, lane = tid & 63, wave = tid >> 6, nw = blockDim.x >> 6;
    const int gw = blockIdx.x * nw + wave, NGW = gridDim.x * nw;
    const h16* YE = (const h16*)(P.ws + WS_RG);
    for (int r = gw; r < NX; r += NGW) {
        f32x4* hr = (f32x4*)(P.out + (size_t)r * DM) + lane;
        const h16x4* y0 = (const h16x4*)(YE + (size_t)(2 * r) * DM) + lane; const h16x4* y1 = (const h16x4*)(YE + (size_t)(2 * r + 1) * DM) + lane;
        f32x4 v[4]; float s = 0.f;
#pragma unroll
        for (int j = 0; j < 4; ++j) { const h16x4 a = y0[64 * j], b = y1[64 * j]; v[j] = hr[64 * j];
            v[j].x += (float)a[0] + (float)b[0]; v[j].y += (float)a[1] + (float)b[1]; v[j].z += (float)a[2] + (float)b[2]; v[j].w += (float)a[3] + (float)b[3];
            s += (v[j].x * v[j].x + v[j].y * v[j].y) + (v[j].z * v[j].z + v[j].w * v[j].w); }
        const float rs = rsqrtf(wave_sum(s) * (1.f / DM) + EPS);
#pragma unroll
        for (int j = 0; j < 4; ++j) { const f32x4 g = ((const f32x4*)P.final_g)[lane + 64 * j]; hr[64 * j] = (f32x4){v[j].x * rs * g.x, v[j].y * rs * g.y, v[j].z * rs * g.z, v[j].w * rs * g.w}; }
    }
}

#define LAS __attribute__((address_space(3)))
#define XB_TMO      128
#define XB_XCNT(j)  (256  + 64 * (j))
#define XB_XSUB(j)  (1280 + 64 * (j))
#define XB_XGEN(j)  (2304 + 64 * (j))
#define XB_TOP      3328
#define XB_TOPGEN   3392
#define XCD_BAR_WORDS 3456
#define XB_SPIN_CAP (1u << 18)
constexpr int CW_BAR = 4096;
static_assert((CW_BAR + XCD_BAR_WORDS) * 4 <= (int)CTL_BYTES, "barrier words inside the memset region");
__device__ __forceinline__ unsigned xb_ld(unsigned* p)              { return __hip_atomic_load(p, __ATOMIC_RELAXED, __HIP_MEMORY_SCOPE_AGENT); }
__device__ __forceinline__ unsigned xb_add(unsigned* p, unsigned v) { return __hip_atomic_fetch_add(p, v, __ATOMIC_RELAXED, __HIP_MEMORY_SCOPE_AGENT); }
__device__ __forceinline__ unsigned xb_xcc_id() { return (unsigned)__builtin_amdgcn_s_getreg((3 << 11) | 20) & 0xFu; }
#define XB_SPIN(cond, bar) do { unsigned _sp = 0; while (cond) { __builtin_amdgcn_s_sleep(1); \
    if ((++_sp & 255u) == 0u) { if (xb_ld(&(bar)[XB_TMO])) break; if (_sp > XB_SPIN_CAP) { atomicAdd(&(bar)[XB_TMO], 1u); break; } } } } while (0)
struct XcdBarrier { unsigned* bar; unsigned x; volatile LAS unsigned* st; };
__device__ __forceinline__ XcdBarrier xcd_barrier_post(unsigned* bar, volatile LAS unsigned* st) {
    XcdBarrier b; b.bar = bar; b.x = xb_xcc_id(); b.st = st;
    if (threadIdx.x == 0) (void)xb_add(&bar[XB_XCNT(b.x)], 1u);
    return b;
}
__device__ __forceinline__ void xcd_barrier_complete(unsigned* bar, unsigned x, unsigned& nloc, unsigned& nx) {
    const unsigned G = gridDim.x * gridDim.y * gridDim.z;
    unsigned sum, cnt, mine, sp = 0u;
    for (;;) {
        sum = 0u; cnt = 0u; mine = 0u;
#pragma unroll
        for (unsigned j = 0; j < 16; ++j) { const unsigned c = xb_ld(&bar[XB_XCNT(j)]); sum += c; cnt += (c > 0u) ? 1u : 0u; mine = (j == x) ? c : mine; }
        if (sum == G) break;
        __builtin_amdgcn_s_sleep(1);
        if ((++sp & 255u) == 0u) { if (xb_ld(&bar[XB_TMO])) break; if (sp > XB_SPIN_CAP) { atomicAdd(&bar[XB_TMO], 1u); break; } }
    }
    nloc = mine > 0u ? mine : 1u; nx = cnt > 0u ? cnt : 1u;
}
__device__ __forceinline__ void xcd_barrier(const XcdBarrier& b) {
    asm volatile("s_waitcnt vmcnt(0)" ::: "memory");
    __syncthreads();
    if (threadIdx.x == 0) {
        unsigned* bar = b.bar;
        __builtin_amdgcn_s_waitcnt(0);
        unsigned nloc = b.st[0], nx = b.st[1];
        if (nloc == 0u) { xcd_barrier_complete(bar, b.x, nloc, nx); b.st[0] = nloc; b.st[1] = nx; }
        const unsigned old = xb_add(&bar[XB_XSUB(b.x)], 1u);
        const unsigned gen = old / nloc;
        if (old + 1u == (gen + 1u) * nloc) {
            __builtin_amdgcn_fence(__ATOMIC_RELEASE, "agent");
            asm volatile("s_waitcnt vmcnt(0)" ::: "memory");
            const unsigned og = xb_add(&bar[XB_TOP], 1u);
            const unsigned tg = og / nx;
            if (og + 1u == (tg + 1u) * nx) xb_add(&bar[XB_TOPGEN], 1u);
            else XB_SPIN(xb_ld(&bar[XB_TOPGEN]) == tg, bar);
            __builtin_amdgcn_fence(__ATOMIC_ACQUIRE, "agent");
            xb_add(&bar[XB_XGEN(b.x)], 1u);
            asm volatile("s_waitcnt vmcnt(0)" ::: "memory");
        } else {
            XB_SPIN(xb_ld(&bar[XB_XGEN(b.x)]) == gen, bar);
            __builtin_amdgcn_fence(__ATOMIC_ACQUIRE, "agent");
            asm volatile("s_waitcnt vmcnt(0)" ::: "memory");
        }
    }
    __syncthreads();
}

constexpr int NWAVES = 8, LDS_BYTES = 147456, MISC_OFF = 131072 + 320;
constexpr int N_PHASES = 12;
struct Args { Params P; int ph_lo, ph_hi, use_cg, pad; };
__global__ void __launch_bounds__(NWAVES * 64, 2) mk_fwd(Args a) {
    extern __shared__ __attribute__((aligned(16))) unsigned char lds_raw[];
    float* lds = (float*)lds_raw;
    volatile LAS unsigned* MISC = (volatile LAS unsigned*)((LAS unsigned char*)lds_raw + MISC_OFF);
    if (threadIdx.x < 32) MISC[threadIdx.x] = 0u;
    __syncthreads();
    const bool one = (a.ph_hi - a.ph_lo) > 1;
    XcdBarrier bar; bar.bar = (unsigned*)(a.P.ws + WS_CTL) + CW_BAR; bar.x = 0; bar.st = nullptr;
    if (one) bar = xcd_barrier_post((unsigned*)(a.P.ws + WS_CTL) + CW_BAR, MISC + 8);
    if (a.use_cg) cooperative_groups::this_grid().sync();
    const Params& P = a.P;
#define PHASE(k, body) if (a.ph_lo <= (k) && (k) < a.ph_hi) { body; if ((k) + 1 < a.ph_hi) xcd_barrier(bar); }
    PHASE(0, ph0_prologue(P, lds))
    PHASE(1, ph1_zgemm(P))
    PHASE(2, ph2_attn(P))
    PHASE(3, ph2_pool(P))
    PHASE(4, ph2b_moew(P, lds))
    PHASE(5, ph3a_mixed<0>(P))
    PHASE(6, ph3a_mixed<1>(P))
    PHASE(7, ph3b_h1(P))
    PHASE(8, ph3c_route(P))
    PHASE(9, ph4_moe1(P))
    PHASE(10, ph5_moe2(P))
    PHASE(11, ph6_final(P))
#undef PHASE
}

#ifndef MK_N_LAUNCHES
#define MK_N_LAUNCHES 1
#endif
extern "C" void kernel_launch(void* const* d_in, const int* in_sizes, int n_in, void* d_out, int out_size, void* d_ws, size_t ws_size, hipStream_t stream) {
    static int grid = 0;
    if (grid == 0) {
        if (n_in != 24 || in_sizes[0] != NX * DM || out_size != NX * DM || ws_size < WS_END) {
            fprintf(stderr, "kernel_launch: unexpected shapes (n_in %d, in0 %d, out %d, ws %zu); nothing launched\n", n_in, n_in > 0 ? in_sizes[0] : -1, out_size, ws_size); grid = -1; return; }
        int dev = 0, cus = 0, per_cu = 0;
        if (hipGetDevice(&dev) != hipSuccess || hipDeviceGetAttribute(&cus, hipDeviceAttributeMultiprocessorCount, dev) != hipSuccess) { grid = -1; return; }
        if (hipFuncSetAttribute((const void*)mk_fwd, hipFuncAttributeMaxDynamicSharedMemorySize, LDS_BYTES) != hipSuccess) { fprintf(stderr, "kernel_launch: hipFuncSetAttribute failed\n"); grid = -1; return; }
        if (hipOccupancyMaxActiveBlocksPerMultiprocessor(&per_cu, (const void*)mk_fwd, NWAVES * 64, LDS_BYTES) != hipSuccess || per_cu < 1) { fprintf(stderr, "kernel_launch: occupancy query says %d blocks per CU\n", per_cu); (void)hipGetLastError(); grid = -1; return; }
        grid = cus;
    }
    if (grid < 0) return;
    (void)hipMemsetAsync((char*)d_ws + WS_CTL, 0, CTL_BYTES, stream);
    Args a{};
    const float** pp = (const float**)&a.P;
    for (int i = 0; i < 24; ++i) pp[i] = (const float*)d_in[i];
    a.P.out = (float*)d_out; a.P.ws = (unsigned char*)d_ws;
    if (MK_N_LAUNCHES == 1) {
        a.ph_lo = 0; a.ph_hi = N_PHASES;
        void* args[] = {&a};
        hipError_t e = hipLaunchCooperativeKernel((const void*)mk_fwd, dim3(grid), dim3(NWAVES * 64), args, LDS_BYTES, stream);
        if (e != hipSuccess) fprintf(stderr, "kernel_launch: cooperative launch failed: %s (grid %d)\n", hipGetErrorString(e), grid);
    } else {
        for (int k = 0; k < N_PHASES; ++k) { a.ph_lo = k; a.ph_hi = k + 1; hipLaunchKernelGGL(mk_fwd, dim3(grid), dim3(NWAVES * 64), LDS_BYTES, stream, a); }
    }
}
```

```cpp
#include <hip/hip_runtime.h>
#include <hip/hip_cooperative_groups.h>
#include <cstdio>
#include <cstdint>

typedef _Float16 h16;
typedef _Float16 h16x2 __attribute__((ext_vector_type(2)));
typedef _Float16 h16x4 __attribute__((ext_vector_type(4)));
typedef _Float16 h16x8 __attribute__((ext_vector_type(8)));
typedef float f32x2 __attribute__((ext_vector_type(2)));
typedef float f32x4 __attribute__((ext_vector_type(4)));
typedef unsigned u32x2 __attribute__((ext_vector_type(2)));
typedef unsigned u32x4 __attribute__((ext_vector_type(4)));

constexpr int NB = 8, SEQ = 2048, NMETA = 16, TT = SEQ + NMETA, DM = 1024;
constexpr int NX = NB * SEQ;
constexpr int MROWS = 16640;
constexpr int NH = 8, HD = 64, VD = 128;
constexpr int IN_W = 5632, O_K = 1024, O_V = 2048, O_P = 3072, O_G = 3584, PW = 512;
constexpr int NE = 16, DE = 512;
constexpr float EPS = 1e-6f;
constexpr float C2 = 0.125f * 1.4426950408889634f;
constexpr float LAMBDA_INIT = 0.2f;

constexpr size_t MiB = 1u << 20;
constexpr size_t WS_CTL = 0, CTL_BYTES = 1 * MiB;
constexpr size_t WS_ROPE = 1 * MiB;
constexpr size_t WS_LAM = 1 * MiB + 768 * 1024;
constexpr size_t WS_TOKW = 2 * MiB;
constexpr size_t WS_LIST = 3 * MiB;
constexpr size_t WS_WIN = 4 * MiB;
constexpr size_t WS_WA = 15 * MiB;
constexpr size_t WS_WEFF = 17 * MiB;
constexpr size_t WS_WOUT = 18 * MiB;
constexpr size_t WS_RA = 20 * MiB;
constexpr size_t WS_RB = WS_RA + 33 * MiB - MiB / 2;
constexpr size_t WS_RC = WS_RB + 33 * MiB - MiB / 2;
constexpr size_t WS_RD = WS_RC + 33 * MiB - MiB / 2;
constexpr size_t WS_RE = WS_RD + 33 * MiB - MiB / 2;
constexpr size_t WS_RF = WS_RE + 16 * MiB + MiB / 4;
constexpr size_t WS_RG = WS_RF + 16 * MiB;
constexpr size_t WS_END = WS_RG + 64 * MiB;
static_assert(WS_END <= 256 * MiB, "workspace map");
constexpr int CW_CNT = 64;

struct Params {
    const float *x, *meta, *norm1_g, *w_in, *b_gate, *lq1, *lk1, *lq2, *lk2, *subln_g, *pool_w, *pool_scale, *w_attn_br, *w_pool_br, *w_out, *norm2_g,
                *w_rg, *b_rg, *w_re, *b_re, *w_eg, *w_eu, *w_ed, *final_g;
    float* out; unsigned char* ws;
};

__device__ __forceinline__ unsigned pk2(float a, float b) { f32x2 v = {a, b}; h16x2 h = __builtin_convertvector(v, h16x2); return __builtin_bit_cast(unsigned, h); }
__device__ __forceinline__ float wave_sum(float v) {
#pragma unroll
    for (int o = 1; o < 64; o <<= 1) v += __shfl_xor(v, o);
    return v;
}
__device__ __forceinline__ float wave_max(float v) {
#pragma unroll
    for (int o = 1; o < 64; o <<= 1) v = fmaxf(v, __shfl_xor(v, o));
    return v;
}
__device__ __forceinline__ int pos_of_row(int r) { return r < NX ? NMETA + (r & (SEQ - 1)) : r - NX; }
__device__ __forceinline__ int row_of_pos(int b, int p) { return p < NMETA ? NX + p : b * SEQ + p - NMETA; }

template <class RowPtr, class Epi>
__device__ __forceinline__ void wgemm64(const RowPtr rowptr, const h16* Bt_tile, int K, int lane, const Epi epi) {
    const int fr = lane & 15, fq = lane >> 4;
    const h16* ap0 = rowptr(fr) + fq * 8; const h16* ap1 = rowptr(16 + fr) + fq * 8; const h16* ap2 = rowptr(32 + fr) + fq * 8; const h16* ap3 = rowptr(48 + fr) + fq * 8;
    const h16* bp = Bt_tile + (size_t)fr * K + fq * 8;
    f32x4 acc[4][4];
#pragma unroll
    for (int m = 0; m < 4; ++m)
#pragma unroll
        for (int n = 0; n < 4; ++n) acc[m][n] = (f32x4){0.f, 0.f, 0.f, 0.f};
#pragma unroll 2
    for (int k0 = 0; k0 < K; k0 += 32) {
        h16x8 a[4], b[4];
        a[0] = *(const h16x8*)(ap0 + k0); a[1] = *(const h16x8*)(ap1 + k0); a[2] = *(const h16x8*)(ap2 + k0); a[3] = *(const h16x8*)(ap3 + k0);
#pragma unroll
        for (int n = 0; n < 4; ++n) b[n] = *(const h16x8*)(bp + (size_t)n * 16 * K + k0);
#pragma unroll
        for (int m = 0; m < 4; ++m)
#pragma unroll
            for (int n = 0; n < 4; ++n) acc[m][n] = __builtin_amdgcn_mfma_f32_16x16x32_f16(b[n], a[m], acc[m][n], 0, 0, 0);
    }
#pragma unroll
    for (int m = 0; m < 4; ++m)
#pragma unroll
        for (int n = 0; n < 4; ++n) epi(m * 16 + fr, n * 16 + fq * 4, acc[m][n]);
}

template <class Src>
__device__ __forceinline__ void transpose_item(const Src src, int K, h16* WT, int nblk, int item, float* scr, int lane) {
    const int kb = item / nblk, nb = item % nblk, k0 = 64 * kb, n0 = 32 * nb;
#pragma unroll 8
    for (int i = 0; i < 32; ++i) { const int kk = 2 * i + (lane >> 5); scr[kk * 33 + (lane & 31)] = src(k0 + kk, n0 + (lane & 31)); }
    __builtin_amdgcn_s_waitcnt(0xC07F); __builtin_amdgcn_wave_barrier();
    const int c = lane & 7;
#pragma unroll
    for (int j = 0; j < 4; ++j) { const int n = (lane >> 3) + 8 * j; const float* s = scr + (8 * c) * 33 + n;
        u32x4 o; o.x = pk2(s[0 * 33], s[1 * 33]); o.y = pk2(s[2 * 33], s[3 * 33]); o.z = pk2(s[4 * 33], s[5 * 33]); o.w = pk2(s[6 * 33], s[7 * 33]);
        *(u32x4*)(WT + (size_t)(n0 + n) * K + k0 + 8 * c) = o; }
    __builtin_amdgcn_s_waitcnt(0xC07F); __builtin_amdgcn_wave_barrier();
}
__device__ __forceinline__ int win_src_col(int n) {
    if (n < O_V) { const int p = n & 63; return (n & ~63) + (p >> 1) + 32 * (p & 1); }
    if (n < O_G) return n;
    const int q = n - O_G; return O_G + (q & 1) * DM + (q >> 1);
}

__device__ __forceinline__ void ph0_prologue(const Params& P, float* lds) {
    const int tid = threadIdx.x, lane = tid & 63, wave = tid >> 6, nw = blockDim.x >> 6;
    const int gw = blockIdx.x * nw + wave, NGW = gridDim.x * nw;
    const int gt = blockIdx.x * blockDim.x + tid, NGT = gridDim.x * blockDim.x;
    unsigned char* ws = P.ws;
    float* rope = (float*)(ws + WS_ROPE);
    for (int it = gt; it < TT * 32; it += NGT) {
        const int t = it >> 5, i = it & 31;
        const float inv = 1.0f / powf(10000.0f, (float)(2 * i) / 64.0f);
        const float ang = (float)t * inv;
        rope[2 * it] = (float)cos((double)ang); rope[2 * it + 1] = (float)sin((double)ang);
    }
    if (gt == 0) {
        float s1 = 0.f, s2 = 0.f;
        for (int i = 0; i < HD; ++i) { s1 += P.lq1[i] * P.lk1[i]; s2 += P.lq2[i] * P.lk2[i]; }
        *(float*)(ws + WS_LAM) = expf(s1) - expf(s2) + LAMBDA_INIT;
    }
    float* scr = lds + wave * (64 * 33);
    {
        h16* WinT = (h16*)(ws + WS_WIN); const float* w = P.w_in;
        auto src = [w](int k, int n) { return w[(size_t)k * IN_W + win_src_col(n)]; };
        for (int it = gw; it < (DM / 64) * (IN_W / 32); it += NGW) transpose_item(src, DM, WinT, IN_W / 32, it, scr, lane);
    }
    {
        h16* WaT = (h16*)(ws + WS_WA); const float* w = P.w_attn_br;
        auto src = [w](int k, int n) { return w[(size_t)k * DM + n]; };
        for (int it = gw; it < (DM / 64) * (DM / 32); it += NGW) transpose_item(src, DM, WaT, DM / 32, it, scr, lane);
    }
    {
        h16* WoT = (h16*)(ws + WS_WOUT); const float* w = P.w_out;
        auto src = [w](int k, int n) { return w[(size_t)k * DM + n]; };
        for (int it = gw; it < (DM / 64) * (DM / 32); it += NGW) transpose_item(src, DM, WoT, DM / 32, it, scr, lane);
    }
    {
        h16* WeT = (h16*)(ws + WS_WEFF);
        for (int it = gw; it < 4 * 16 * 16; it += NGW) {
            const int nb = it & 15, c8 = (it >> 4) & 15, g = it >> 8, n = nb * 64 + lane;
            float acc[8];
#pragma unroll
            for (int j = 0; j < 8; ++j) acc[j] = 0.f;
            for (int d = 0; d < 128; ++d) {
                const float wv = P.w_pool_br[(size_t)(g * 128 + d) * DM + n] * P.pool_scale[g * 128 + d];
#pragma unroll
                for (int j = 0; j < 8; ++j) acc[j] += P.pool_w[((size_t)g * 128 + c8 * 8 + j) * 128 + d] * wv;
            }
            u32x4 o; o.x = pk2(acc[0], acc[1]); o.y = pk2(acc[2], acc[3]); o.z = pk2(acc[4], acc[5]); o.w = pk2(acc[6], acc[7]);
            *(u32x4*)(WeT + (size_t)n * PW + g * 128 + c8 * 8) = o;
        }
    }
    {
        h16* HN = (h16*)(ws + WS_RA);
        for (int r = gw; r < MROWS; r += NGW) {
            u32x2* o = (u32x2*)(HN + (size_t)r * DM) + lane;
            if (r >= NX + NMETA) {
#pragma unroll
                for (int j = 0; j < 4; ++j) o[64 * j] = (u32x2){0u, 0u};
                continue;
            }
            const float* src = r < NX ? P.x + (size_t)r * DM : P.meta + (size_t)(r - NX) * DM;
            const f32x4* xr = (const f32x4*)src + lane;
            f32x4 v[4]; float s = 0.f;
#pragma unroll
            for (int j = 0; j < 4; ++j) { v[j] = xr[64 * j]; s += (v[j].x * v[j].x + v[j].y * v[j].y) + (v[j].z * v[j].z + v[j].w * v[j].w); }
            const float rs = rsqrtf(wave_sum(s) * (1.f / DM) + EPS);
#pragma unroll
            for (int j = 0; j < 4; ++j) { const f32x4 g = ((const f32x4*)P.norm1_g)[lane + 64 * j];
                o[64 * j] = (u32x2){pk2(v[j].x * rs * g.x, v[j].y * rs * g.y), pk2(v[j].z * rs * g.z, v[j].w * rs * g.w)}; }
        }
    }
}

struct EpiZ {
    const float* rope; const float* b_gate; h16 *Q, *K, *V, *U, *G0, *R;
    __device__ __forceinline__ void operator()(int row, int col, f32x4 v) const {
        if (col < O_V) {
            const int t = pos_of_row(row); const int i0 = (col & 63) >> 1;
            const f32x4 cs = *(const f32x4*)(rope + ((size_t)t * 32 + i0) * 2);
            float o0 = v.x * cs.x - v.y * cs.y, o1 = v.y * cs.x + v.x * cs.y, o2 = v.z * cs.z - v.w * cs.w, o3 = v.w * cs.z + v.z * cs.w;
            if (col < O_K) { o0 *= C2; o1 *= C2; o2 *= C2; o3 *= C2; *(u32x2*)(Q + (size_t)row * DM + col) = (u32x2){pk2(o0, o1), pk2(o2, o3)}; }
            else *(u32x2*)(K + (size_t)row * DM + (col - O_K)) = (u32x2){pk2(o0, o1), pk2(o2, o3)};
        } else if (col < O_P) { *(u32x2*)(V + (size_t)row * DM + (col - O_V)) = (u32x2){pk2(v.x, v.y), pk2(v.z, v.w)};
        } else if (col < O_G) { *(u32x2*)(U + (size_t)row * PW + (col - O_P)) = (u32x2){pk2(v.x, v.y), pk2(v.z, v.w)};
        } else if (row < NX) {
            const int j = (col - O_G) >> 1;
            const float a0 = v.x + b_gate[j], a1 = v.y + b_gate[DM + j], c0 = v.z + b_gate[j + 1], c1 = v.w + b_gate[DM + j + 1];
            const float ea0 = __expf(-a0), ea1 = __expf(-a1), ec0 = __expf(-c0), ec1 = __expf(-c1);
            const float g0a = 1.f / (1.f + ea0), g0c = 1.f / (1.f + ec0);
            const float ra = (1.f + ea0) / (1.f + ea1), rc = (1.f + ec0) / (1.f + ec1);
            *(unsigned*)(G0 + (size_t)row * DM + j) = pk2(g0a, g0c);
            *(unsigned*)(R + (size_t)row * DM + j) = pk2(ra, rc);
        }
    }
};
__device__ __forceinline__ void ph1_zgemm(const Params& P) {
    const int tid = threadIdx.x, lane = tid & 63, wave = tid >> 6, nw = blockDim.x >> 6;
    const int gw = blockIdx.x * nw + wave, NGW = gridDim.x * nw;
    unsigned char* ws = P.ws;
    const h16* HN = (const h16*)(ws + WS_RA); const h16* WinT = (const h16*)(ws + WS_WIN);
    EpiZ E{(const float*)(ws + WS_ROPE), P.b_gate, (h16*)(ws + WS_RB), (h16*)(ws + WS_RC), (h16*)(ws + WS_RD), (h16*)(ws + WS_RE), (h16*)(ws + WS_RG), (h16*)(ws + WS_RG + 32 * MiB)};
    constexpr int NT_N = IN_W / 64, NT_M = MROWS / 64;
    for (int it = gw; it < NT_M * NT_N; it += NGW) {
        const int mt = it / NT_N, nt = it % NT_N;
        auto rowptr = [HN, mt](int r) { return HN + (size_t)(mt * 64 + r) * DM; };
        auto epi = [&E, mt, nt](int r, int c, f32x4 v) { E(mt * 64 + r, nt * 64 + c, v); };
        wgemm64(rowptr, WinT + (size_t)nt * 64 * DM, DM, lane, epi);
    }
}

__device__ __forceinline__ void ph2_attn(const Params& P) {
    const int tid = threadIdx.x, lane = tid & 63, wave = tid >> 6, nw = blockDim.x >> 6;
    const int gw = blockIdx.x * nw + wave, NGW = gridDim.x * nw;
    unsigned char* ws = P.ws;
    const h16* Q = (const h16*)(ws + WS_RB); const h16* Kb = (const h16*)(ws + WS_RC); const h16* Vb = (const h16*)(ws + WS_RD); h16* A = (h16*)(ws + WS_RB);
    const float lam = *(const float*)(ws + WS_LAM);
    for (int task = gw; task < NX * NH; task += NGW) {
        const int r = __builtin_amdgcn_readfirstlane(task >> 3), h = __builtin_amdgcn_readfirstlane(task & 7);
        const int b = r >> 11, i = r & (SEQ - 1), t = NMETA + i;
        h16x2 qv[64];
        { const h16x8* qp = (const h16x8*)(Q + (size_t)r * DM + h * 128);
#pragma unroll
          for (int j = 0; j < 16; ++j) { const h16x8 q8 = qp[j]; qv[4 * j] = (h16x2){q8[0], q8[1]}; qv[4 * j + 1] = (h16x2){q8[2], q8[3]}; qv[4 * j + 2] = (h16x2){q8[4], q8[5]}; qv[4 * j + 3] = (h16x2){q8[6], q8[7]}; } }
        float m0 = -1e30f, m1 = -1e30f, l0 = 0.f, l1 = 0.f; f32x2 O0 = {0.f, 0.f}, O1 = {0.f, 0.f};
        const int ntile = (t + 64) >> 6;
        for (int kt = 0; kt < ntile; ++kt) {
            const int p = kt * 64 + lane; const bool valid = p <= t; const int pc = valid ? p : t;
            const h16* krow = Kb + (size_t)row_of_pos(b, pc) * DM + h * 128;
            float s0 = 0.f, s1 = 0.f;
#pragma unroll
            for (int j = 0; j < 8; ++j) { const h16x8 k8 = ((const h16x8*)krow)[j];
                s0 = __builtin_amdgcn_fdot2((h16x2){k8[0], k8[1]}, qv[4 * j], s0, false); s0 = __builtin_amdgcn_fdot2((h16x2){k8[2], k8[3]}, qv[4 * j + 1], s0, false);
                s0 = __builtin_amdgcn_fdot2((h16x2){k8[4], k8[5]}, qv[4 * j + 2], s0, false); s0 = __builtin_amdgcn_fdot2((h16x2){k8[6], k8[7]}, qv[4 * j + 3], s0, false); }
#pragma unroll
            for (int j = 8; j < 16; ++j) { const h16x8 k8 = ((const h16x8*)krow)[j];
                s1 = __builtin_amdgcn_fdot2((h16x2){k8[0], k8[1]}, qv[4 * j], s1, false); s1 = __builtin_amdgcn_fdot2((h16x2){k8[2], k8[3]}, qv[4 * j + 1], s1, false);
                s1 = __builtin_amdgcn_fdot2((h16x2){k8[4], k8[5]}, qv[4 * j + 2], s1, false); s1 = __builtin_amdgcn_fdot2((h16x2){k8[6], k8[7]}, qv[4 * j + 3], s1, false); }
            if (!valid) { s0 = -1e30f; s1 = -1e30f; }
            const float mn0 = fmaxf(m0, wave_max(s0)), mn1 = fmaxf(m1, wave_max(s1));
            const float al0 = exp2f(m0 - mn0), al1 = exp2f(m1 - mn1);
            const float p0 = valid ? exp2f(s0 - mn0) : 0.f, p1 = valid ? exp2f(s1 - mn1) : 0.f;
            l0 = l0 * al0 + wave_sum(p0); l1 = l1 * al1 + wave_sum(p1); m0 = mn0; m1 = mn1;
            O0 *= al0; O1 *= al1;
            const int nk = min(64, t + 1 - kt * 64);
            for (int j = 0; j < nk; ++j) {
                const float a0 = __int_as_float(__builtin_amdgcn_readlane(__float_as_int(p0), j)); const float a1 = __int_as_float(__builtin_amdgcn_readlane(__float_as_int(p1), j));
                const h16x2 v2 = *(const h16x2*)(Vb + (size_t)row_of_pos(b, kt * 64 + j) * DM + h * 128 + 2 * lane);
                const float vx = (float)v2[0], vy = (float)v2[1];
                O0.x += a0 * vx; O0.y += a0 * vy; O1.x += a1 * vx; O1.y += a1 * vy;
            }
        }
        const float il0 = 1.f / l0, il1 = lam / l1;
        const float ox = O0.x * il0 - O1.x * il1, oy = O0.y * il0 - O1.y * il1;
        const float ss = wave_sum(ox * ox + oy * oy);
        const float rs = rsqrtf(ss * (1.f / VD) + EPS) * (1.f - LAMBDA_INIT);
        *(unsigned*)(A + (size_t)r * DM + h * 128 + 2 * lane) = pk2(ox * rs * P.subln_g[2 * lane], oy * rs * P.subln_g[2 * lane + 1]);
    }
}
__device__ __forceinline__ void ph2_pool(const Params& P) {
    const int gt = blockIdx.x * blockDim.x + threadIdx.x, NGT = gridDim.x * blockDim.x;
    unsigned char* ws = P.ws;
    const h16* U = (const h16*)(ws + WS_RE); h16* Y = (h16*)(ws + WS_RF);
    for (int it = gt; it < NX * (PW / 2); it += NGT) {
        const int r = it >> 8, c = (it & 255) * 2, g = c >> 7, w = 2 << g;
        const int b = r >> 11, t = NMETA + (r & (SEQ - 1));
        float sx = 0.f, sy = 0.f;
        for (int p = t - w + 1; p <= t; ++p) { const h16x2 u2 = *(const h16x2*)(U + (size_t)row_of_pos(b, p) * PW + c); sx += (float)u2[0]; sy += (float)u2[1]; }
        const h16x2 u0 = *(const h16x2*)(U + (size_t)r * PW + c);
        const float iw = 1.f / (float)w;
        *(unsigned*)(Y + (size_t)r * PW + c) = pk2(sx * iw - (float)u0[0], sy * iw - (float)u0[1]);
    }
}

__device__ __forceinline__ void ph2b_moew(const Params& P, float* lds) {
    const int tid = threadIdx.x, lane = tid & 63, wave = tid >> 6, nw = blockDim.x >> 6;
    const int gw = blockIdx.x * nw + wave, NGW = gridDim.x * nw;
    unsigned char* ws = P.ws; float* scr = lds + wave * (64 * 33);
    h16* WguT = (h16*)(ws + WS_RD); h16* WdnT = (h16*)(ws + WS_RC);
    constexpr int I_GU = (DM / 64) * (2 * DE / 32), I_DN = (DE / 64) * (DM / 32);
    for (int it = gw; it < NE * I_GU; it += NGW) {
        const int e = it / I_GU, r = it % I_GU; const float* wg = P.w_eg + (size_t)e * DM * DE; const float* wu = P.w_eu + (size_t)e * DM * DE;
        const long long du = (const char*)wu - (const char*)wg;
        auto src = [wg, du](int k, int n) { return *(const float*)((const char*)(wg + (size_t)k * DE + (n >> 1)) + ((n & 1) ? du : 0ll)); };
        transpose_item(src, DM, WguT + (size_t)e * (2 * DE) * DM, 2 * DE / 32, r, scr, lane);
    }
    for (int it = gw; it < NE * I_DN; it += NGW) {
        const int e = it / I_DN, r = it % I_DN; const float* wd = P.w_ed + (size_t)e * DE * DM;
        auto src = [wd](int k, int n) { return wd[(size_t)k * DM + n]; };
        transpose_item(src, DE, WdnT + (size_t)e * DM * DE, DM / 32, r, scr, lane);
    }
}

template <int PASS>
__device__ __forceinline__ void ph3a_mixed(const Params& P) {
    const int tid = threadIdx.x, lane = tid & 63, wave = tid >> 6, nw = blockDim.x >> 6;
    const int gw = blockIdx.x * nw + wave, NGW = gridDim.x * nw;
    unsigned char* ws = P.ws;
    const h16* A = (const h16*)(ws + WS_RB); const h16* Y = (const h16*)(ws + WS_RF);
    const h16* WaT = (const h16*)(ws + WS_WA); const h16* WeT = (const h16*)(ws + WS_WEFF);
    const h16* G0 = (const h16*)(ws + WS_RG); const h16* R = (const h16*)(ws + WS_RG + 32 * MiB); h16* MX = (h16*)(ws + WS_RA);
    constexpr int NT_N = DM / 64, NT_M = NX / 64;
    for (int it = gw; it < NT_M * NT_N; it += NGW) {
        const int mt = it / NT_N, nt = it % NT_N;
        if (PASS == 0) {
            auto rowptr = [Y, mt](int r) { return Y + (size_t)(mt * 64 + r) * PW; };
            auto epi = [=](int r, int c, f32x4 v) { const size_t o = (size_t)(mt * 64 + r) * DM + nt * 64 + c;
                const h16x4 g = *(const h16x4*)(G0 + o), q = *(const h16x4*)(R + o);
                *(u32x2*)(MX + o) = (u32x2){pk2(v.x * (float)g[0] * (float)q[0], v.y * (float)g[1] * (float)q[1]), pk2(v.z * (float)g[2] * (float)q[2], v.w * (float)g[3] * (float)q[3])}; };
            wgemm64(rowptr, WeT + (size_t)nt * 64 * PW, PW, lane, epi);
        } else {
            auto rowptr = [A, mt](int r) { return A + (size_t)(mt * 64 + r) * DM; };
            auto epi = [=](int r, int c, f32x4 v) { const size_t o = (size_t)(mt * 64 + r) * DM + nt * 64 + c;
                const h16x4 g = *(const h16x4*)(G0 + o), t1 = *(const h16x4*)(MX + o);
                *(u32x2*)(MX + o) = (u32x2){pk2(v.x * (float)g[0] + (float)t1[0], v.y * (float)g[1] + (float)t1[1]), pk2(v.z * (float)g[2] + (float)t1[2], v.w * (float)g[3] + (float)t1[3])}; };
            wgemm64(rowptr, WaT + (size_t)nt * 64 * DM, DM, lane, epi);
        }
    }
}
__device__ __forceinline__ void ph3b_h1(const Params& P) {
    const int tid = threadIdx.x, lane = tid & 63, wave = tid >> 6, nw = blockDim.x >> 6;
    const int gw = blockIdx.x * nw + wave, NGW = gridDim.x * nw;
    unsigned char* ws = P.ws;
    const h16* MX = (const h16*)(ws + WS_RA); const h16* WoT = (const h16*)(ws + WS_WOUT); const float* x = P.x; float* out = P.out;
    constexpr int NT_N = DM / 64, NT_M = NX / 64;
    for (int it = gw; it < NT_M * NT_N; it += NGW) {
        const int mt = it / NT_N, nt = it % NT_N;
        auto rowptr = [MX, mt](int r) { return MX + (size_t)(mt * 64 + r) * DM; };
        auto epi = [=](int r, int c, f32x4 v) { const size_t o = (size_t)(mt * 64 + r) * DM + nt * 64 + c; *(f32x4*)(out + o) = *(const f32x4*)(x + o) + v; };
        wgemm64(rowptr, WoT + (size_t)nt * 64 * DM, DM, lane, epi);
    }
}
__device__ __forceinline__ void ph3c_route(const Params& P) {
    const int tid = threadIdx.x, lane = tid & 63, wave = tid >> 6, nw = blockDim.x >> 6;
    const int gw = blockIdx.x * nw + wave, NGW = gridDim.x * nw;
    unsigned char* ws = P.ws;
    h16* HN2 = (h16*)(ws + WS_RB); unsigned* cnt = (unsigned*)(ws + WS_CTL) + CW_CNT; int* list = (int*)(ws + WS_LIST); float* tokw = (float*)(ws + WS_TOKW);
    for (int r = gw; r < NX; r += NGW) {
        const f32x4* hr = (const f32x4*)(P.out + (size_t)r * DM) + lane;
        f32x4 v[4]; float s = 0.f;
#pragma unroll
        for (int j = 0; j < 4; ++j) { v[j] = hr[64 * j]; s += (v[j].x * v[j].x + v[j].y * v[j].y) + (v[j].z * v[j].z + v[j].w * v[j].w); }
        const float rs = rsqrtf(wave_sum(s) * (1.f / DM) + EPS);
        float lg[20];
#pragma unroll
        for (int e = 0; e < 20; ++e) lg[e] = 0.f;
        u32x2* o = (u32x2*)(HN2 + (size_t)r * DM) + lane;
#pragma unroll
        for (int j = 0; j < 4; ++j) {
            const f32x4 g = ((const f32x4*)P.norm2_g)[lane + 64 * j];
            const f32x4 hn = {v[j].x * rs * g.x, v[j].y * rs * g.y, v[j].z * rs * g.z, v[j].w * rs * g.w};
            o[64 * j] = (u32x2){pk2(hn.x, hn.y), pk2(hn.z, hn.w)};
            const int k0 = (lane + 64 * j) * 4;
#pragma unroll
            for (int q = 0; q < 4; ++q) {
                const float hv = hn[q]; const f32x4 wg = *(const f32x4*)(P.w_rg + (size_t)(k0 + q) * 4);
                lg[0] += hv * wg.x; lg[1] += hv * wg.y; lg[2] += hv * wg.z; lg[3] += hv * wg.w;
#pragma unroll
                for (int e4 = 0; e4 < 4; ++e4) { const f32x4 we = *(const f32x4*)(P.w_re + (size_t)(k0 + q) * 16 + e4 * 4);
                    lg[4 + e4 * 4] += hv * we.x; lg[5 + e4 * 4] += hv * we.y; lg[6 + e4 * 4] += hv * we.z; lg[7 + e4 * 4] += hv * we.w; }
            }
        }
#pragma unroll
        for (int e = 0; e < 20; ++e) lg[e] = wave_sum(lg[e]);
        if (lane == 0) {
            float gl[4]; int gs = 0;
#pragma unroll
            for (int g = 0; g < 4; ++g) gl[g] = lg[g] + P.b_rg[g];
#pragma unroll
            for (int g = 1; g < 4; ++g) if (gl[g] > gl[gs]) gs = g;
            float den = 0.f;
#pragma unroll
            for (int g = 0; g < 4; ++g) den += expf(gl[g] - gl[gs]);
            const float pg = 1.f / den;
            float el[4];
#pragma unroll
            for (int q = 0; q < 4; ++q) { float a = 0.f;
#pragma unroll
                for (int g = 0; g < 4; ++g) a = (g == gs) ? lg[4 + g * 4 + q] : a;
                el[q] = a + P.b_re[gs * 4 + q]; }
            int i1 = 0;
#pragma unroll
            for (int q = 1; q < 4; ++q) if (el[q] > el[i1]) i1 = q;
            int i2 = (i1 == 0) ? 1 : 0;
#pragma unroll
            for (int q = 0; q < 4; ++q) if (q != i1 && el[q] > el[i2]) i2 = q;
            const float ed = expf(el[i2] - el[i1]);
            const float w1 = pg / (1.f + ed), w2 = pg * ed / (1.f + ed);
            const int e1 = gs * 4 + i1, e2 = gs * 4 + i2;
            const unsigned p1 = atomicAdd(cnt + e1, 1u), p2 = atomicAdd(cnt + e2, 1u);
            list[e1 * NX + p1] = r * 2; list[e2 * NX + p2] = r * 2 + 1;
            tokw[r * 2] = w1; tokw[r * 2 + 1] = w2;
        }
    }
}
__device__ __forceinline__ void ph4_moe1(const Params& P) {
    const int tid = threadIdx.x, lane = tid & 63, wave = tid >> 6, nw = blockDim.x >> 6;
    const int gw = blockIdx.x * nw + wave, NGW = gridDim.x * nw;
    unsigned char* ws = P.ws;
    const h16* HN2 = (const h16*)(ws + WS_RB); const h16* WguT = (const h16*)(ws + WS_RD); h16* ACT = (h16*)(ws + WS_RA);
    const unsigned* cnt = (const unsigned*)(ws + WS_CTL) + CW_CNT; const int* list = (const int*)(ws + WS_LIST);
    for (int it = gw; it < NE * 256 * 16; it += NGW) {
        const int e = it >> 12, rt = (it >> 4) & 255, ct = it & 15;
        const int n_e = (int)cnt[e]; if (rt * 64 >= n_e) continue;
        int off = 0; for (int q = 0; q < e; ++q) off += (int)cnt[q];
        const int* le = list + (size_t)e * NX;
        auto rowptr = [=](int r) { int idx = rt * 64 + r; idx = idx < n_e ? idx : n_e - 1; return HN2 + (size_t)(le[idx] >> 1) * DM; };
        auto epi = [=](int r, int c, f32x4 v) { const int idx = rt * 64 + r; if (idx >= n_e) return;
            const float a0 = v.x / (1.f + __expf(-v.x)) * v.y, a1 = v.z / (1.f + __expf(-v.z)) * v.w;
            *(unsigned*)(ACT + (size_t)(off + idx) * DE + ((ct * 64 + c) >> 1)) = pk2(a0, a1); };
        wgemm64(rowptr, WguT + ((size_t)e * (2 * DE) + ct * 64) * DM, DM, lane, epi);
    }
}
__device__ __forceinline__ void ph5_moe2(const Params& P) {
    const int tid = threadIdx.x, lane = tid & 63, wave = tid >> 6, nw = blockDim.x >> 6;
    const int gw = blockIdx.x * nw + wave, NGW = gridDim.x * nw;
    unsigned char* ws = P.ws;
    const h16* ACT = (const h16*)(ws + WS_RA); const h16* WdnT = (const h16*)(ws + WS_RC); h16* YE = (h16*)(ws + WS_RG);
    const unsigned* cnt = (const unsigned*)(ws + WS_CTL) + CW_CNT; const int* list = (const int*)(ws + WS_LIST); const float* tokw = (const float*)(ws + WS_TOKW);
    for (int it = gw; it < NE * 256 * 16; it += NGW) {
        const int e = it >> 12, rt = (it >> 4) & 255, ct = it & 15;
        const int n_e = (int)cnt[e]; if (rt * 64 >= n_e) continue;
        int off = 0; for (int q = 0; q < e; ++q) off += (int)cnt[q];
        const int* le = list + (size_t)e * NX;
        auto rowptr = [=](int r) { int idx = rt * 64 + r; idx = idx < n_e ? idx : n_e - 1; return ACT + (size_t)(off + idx) * DE; };
        auto epi = [=](int r, int c, f32x4 v) { const int idx = rt * 64 + r; if (idx >= n_e) return;
            const int ts = le[idx]; const float w = tokw[ts];
            *(u32x2*)(YE + (size_t)ts * DM + ct * 64 + c) = (u32x2){pk2(v.x * w, v.y * w), pk2(v.z * w, v.w * w)}; };
        wgemm64(rowptr, WdnT + ((size_t)e * DM + ct * 64) * DE, DE, lane, epi);
    }
}
__device__ __forceinline__ void ph6_final(const Params& P) {
    const int tid = threadIdx.x, lane = tid & 63, wave = tid >> 6, nw = blockDim.x >> 6;
    const int gw = blockIdx.x * nw + wave, NGW = gridDim.x * nw;
    const h16* YE = (const h16*)(P.ws + WS_RG);
    for (int r = gw; r < NX; r += NGW) {
        f32x4* hr = (f32x4*)(P.out + (size_t)r * DM) + lane;
        const h16x4* y0 = (const h16x4*)(YE + (size_t)(2 * r) * DM) + lane; const h16x4* y1 = (const h16x4*)(YE + (size_t)(2 * r + 1) * DM) + lane;
        f32x4 v[4]; float s = 0.f;
#pragma unroll
        for (int j = 0; j < 4; ++j) { const h16x4 a = y0[64 * j], b = y1[64 * j]; v[j] = hr[64 * j];
            v[j].x += (float)a[0] + (float)b[0]; v[j].y += (float)a[1] + (float)b[1]; v[j].z += (float)a[2] + (float)b[2]; v[j].w += (float)a[3] + (float)b[3];
            s += (v[j].x * v[j].x + v[j].y * v[j].y) + (v[j].z * v[j].z + v[j].w * v[j].w); }
        const float rs = rsqrtf(wave_sum(s) * (1.f / DM) + EPS);
#pragma unroll
        for (int j = 0; j < 4; ++j) { const f32x4 g = ((const f32x4*)P.final_g)[lane + 64 * j]; hr[64 * j] = (f32x4){v[j].x * rs * g.x, v[j].y * rs * g.y, v[j].z * rs * g.z, v[j].w * rs * g.w}; }
    }
}

namespace pg8 {
#define PG8_LAS __attribute__((address_space(3)))
constexpr int BM = 256, BK = 64, HALF = 128, HTB = HALF * BK * 2, STAGE_BYTES = 8 * HTB, NXCD = 8, WGM = 8;
__host__ __device__ __forceinline__ int lds_byte(int r, int c) { const int st = (r >> 4) * 2 + (c >> 5), rr = r & 15, cc = c & 31, ob = rr * 64 + cc * 2; return st * 1024 + (ob ^ (((ob >> 9) & 1) << 5)); }
__host__ __device__ __forceinline__ void stage_rc(int b, int& R, int& C) { const int st = b / 1024, sb = b % 1024, swz = sb ^ (((sb >> 9) & 1) << 5); R = (st >> 1) * 16 + swz / 64; C = (st & 1) * 32 + (swz % 64) / 2; }
__host__ __device__ __forceinline__ int perm32(int rho) { const int n = rho >> 4, i = rho & 15; return 8 * (i >> 2) + 4 * n + (i & 3); }
struct Unit { const char* A; const char* B; unsigned lda, ldb; int nt, keep; int pm, pn, x0, x1, gat; const int* rows; };
__device__ __forceinline__ void tile_of(int L, int nM, int nN, int& pm, int& pn) {
    const int nwg = nM * nN; int wgid = L; { const int q = nwg / NXCD, r = nwg % NXCD, xcd = wgid % NXCD, off = wgid / NXCD; wgid = (xcd < r ? xcd * (q + 1) : r * (q + 1) + (xcd - r) * q) + off; }
    const int nig = WGM * nN, gid = wgid / nig, fm = gid * WGM, gsz = (nM - fm) < WGM ? (nM - fm) : WGM;
    pm = fm + ((wgid % nig) % gsz); pn = (wgid % nig) / gsz;
}
template <bool PERM>
__device__ __forceinline__ void unit_voff(const Unit& u, int tid, unsigned (&vA)[2][2], unsigned (&vB)[2][2]) {
#pragma unroll
    for (int i = 0; i < 2; ++i) { int R, C; stage_rc(tid * 16 + i * 8192, R, C); const int Rb = PERM ? ((R & ~31) + perm32(R & 31)) : R;
#pragma unroll
        for (int h = 0; h < 2; ++h) { int ra = R + HALF * h;
            if (u.gat) { const int idx = ra < u.x0 ? ra : u.x0 - 1; ra = u.rows[idx] >> 1; }
            vA[h][i] = (unsigned)ra * u.lda + (unsigned)C * 2u; vB[h][i] = (unsigned)(Rb + HALF * h) * u.ldb + (unsigned)C * 2u; } }
}
template <bool PERM, class Sched, class Epi>
__device__ __forceinline__ void gemm_phase(PG8_LAS unsigned char* lds, const Sched& S, const Epi& E) {
    const int tid = threadIdx.x, wid = __builtin_amdgcn_readfirstlane(tid >> 6), lane = tid & 63, wr = wid >> 2, wc = wid & 3, fr = lane & 15, fq = lane >> 4;
    const size_t kstep = (size_t)(BK * 2);
    const unsigned ldsw = (unsigned)wid * 1024u;
    const int aoff = lds_byte(wr * 64 + fr, fq * 8), boff = lds_byte(wc * 32 + fr, fq * 8);
#define PG8_SA(b, h) (((b) * 2 + (h)) * HTB)
#define PG8_SB(b, h) ((4 + (b) * 2 + (h)) * HTB)
#define PG8_STAGE(bufoff, gbase, voff) do { _Pragma("unroll") for (int _i = 0; _i < 2; ++_i) \
        __builtin_amdgcn_global_load_lds((const unsigned*)((const char*)(gbase) + (voff)[_i]), (PG8_LAS unsigned*)(lds + (bufoff) + ldsw + _i * 8192), 16, 0, 0); } while (0)
#define PG8_LDA(dst, b, h) do { _Pragma("unroll") for (int m = 0; m < 4; ++m) _Pragma("unroll") for (int k = 0; k < 2; ++k) dst[m][k] = *(const PG8_LAS h16x8*)(lds + PG8_SA(b, h) + aoff + m * 2048 + k * 1024); } while (0)
#define PG8_LDB(dst, b, h) do { _Pragma("unroll") for (int n = 0; n < 2; ++n) _Pragma("unroll") for (int k = 0; k < 2; ++k) dst[n][k] = *(const PG8_LAS h16x8*)(lds + PG8_SB(b, h) + boff + n * 2048 + k * 1024); } while (0)
#define PG8_MMA(ai, bj, At, Bt) do { __builtin_amdgcn_s_setprio(1); _Pragma("unroll") for (int m = 0; m < 4; ++m) _Pragma("unroll") for (int n = 0; n < 2; ++n) _Pragma("unroll") for (int k = 0; k < 2; ++k) \
        acc[ai][bj][m][n] = __builtin_amdgcn_mfma_f32_16x16x32_f16(Bt[n][k], At[m][k], acc[ai][bj][m][n], 0, 0, 0); __builtin_amdgcn_s_setprio(0); } while (0)
#define PG8_WAIT_V(n) asm volatile("s_waitcnt vmcnt(" #n ")" ::: "memory")
#define PG8_WAIT_L(n) asm volatile("s_waitcnt lgkmcnt(" #n ")" ::: "memory")
#define PG8_BAR __builtin_amdgcn_s_barrier()
#define PG8_SCHED __builtin_amdgcn_sched_barrier(0)
    Unit cur, nxt; int ui = 0;
    if (!S.next(0, cur)) return;
    f32x4 acc[2][2][4][2];
#pragma unroll
    for (int a = 0; a < 2; ++a)
#pragma unroll
        for (int b = 0; b < 2; ++b)
#pragma unroll
            for (int m = 0; m < 4; ++m)
#pragma unroll
                for (int n = 0; n < 2; ++n) acc[a][b][m][n] = (f32x4){0.f, 0.f, 0.f, 0.f};
    h16x8 At[4][2], B0[2][2], B1[2][2];
    unsigned vA[2][2], vB[2][2], nvA[2][2], nvB[2][2];
    unit_voff<PERM>(cur, tid, vA, vB);
    const char* cA = cur.A; const char* cB = cur.B;
    PG8_STAGE(PG8_SB(0, 0), cB, vB[0]); PG8_STAGE(PG8_SB(0, 1), cB, vB[1]); PG8_STAGE(PG8_SA(0, 0), cA, vA[0]); PG8_STAGE(PG8_SA(0, 1), cA, vA[1]);
    if (wr == 1) PG8_BAR;
    PG8_WAIT_V(2); PG8_BAR;
    PG8_STAGE(PG8_SB(1, 0), cB + kstep, vB[0]); PG8_STAGE(PG8_SA(1, 0), cA + kstep, vA[0]); PG8_STAGE(PG8_SB(1, 1), cB + kstep, vB[1]);
    PG8_WAIT_V(6); PG8_BAR;
    for (;;) {
        const bool has_next = S.next(ui + 1, nxt);
        const char* nA = has_next ? nxt.A : cA; const char* nB = has_next ? nxt.B : cB;
        if (has_next) unit_voff<PERM>(nxt, tid, nvA, nvB);
        else {
#pragma unroll
            for (int h = 0; h < 2; ++h)
#pragma unroll
                for (int i = 0; i < 2; ++i) { nvA[h][i] = vA[h][i]; nvB[h][i] = vB[h][i]; } }
        const int nt = cur.nt;
        for (int t = 0; t < nt; t += 2) {
            const bool last = (t == nt - 2);
            const char* a1 = cA + (size_t)(t + 1) * kstep;
            const char* a2 = last ? nA : cA + (size_t)(t + 2) * kstep; const char* b2 = last ? nB : cB + (size_t)(t + 2) * kstep;
            const char* a3 = a2 + kstep; const char* b3 = b2 + kstep;
            unsigned wA[2][2], wB[2][2];
#pragma unroll
            for (int h = 0; h < 2; ++h)
#pragma unroll
                for (int i = 0; i < 2; ++i) { wA[h][i] = last ? nvA[h][i] : vA[h][i]; wB[h][i] = last ? nvB[h][i] : vB[h][i]; }
            PG8_LDB(B0, 0, 0); PG8_LDB(B1, 0, 1); PG8_SCHED; PG8_LDA(At, 0, 0); PG8_STAGE(PG8_SA(1, 1), a1, vA[1]);
            PG8_WAIT_V(8); PG8_WAIT_L(0); PG8_BAR; PG8_MMA(0, 0, At, B0); PG8_MMA(0, 1, At, B1); PG8_BAR; PG8_SCHED;
            PG8_LDA(At, 0, 1); PG8_STAGE(PG8_SB(0, 0), b2, wB[0]); PG8_STAGE(PG8_SB(0, 1), b2, wB[1]); PG8_STAGE(PG8_SA(0, 0), a2, wA[0]);
            PG8_WAIT_V(8); PG8_WAIT_L(0); PG8_BAR; PG8_MMA(1, 0, At, B0); PG8_MMA(1, 1, At, B1); PG8_BAR; PG8_SCHED;
            PG8_LDB(B0, 1, 0); PG8_LDB(B1, 1, 1); PG8_SCHED; PG8_LDA(At, 1, 0); PG8_STAGE(PG8_SA(0, 1), a2, wA[1]);
            PG8_WAIT_V(8); PG8_WAIT_L(0); PG8_BAR; PG8_MMA(0, 0, At, B0); PG8_MMA(0, 1, At, B1); PG8_BAR; PG8_SCHED;
            PG8_LDA(At, 1, 1); PG8_STAGE(PG8_SB(1, 0), b3, wB[0]); PG8_STAGE(PG8_SB(1, 1), b3, wB[1]); PG8_STAGE(PG8_SA(1, 0), a3, wA[0]);
            PG8_WAIT_V(8); PG8_WAIT_L(0); PG8_BAR; PG8_MMA(1, 0, At, B0); PG8_MMA(1, 1, At, B1); PG8_BAR; PG8_SCHED;
        }
        if (wr == 0) PG8_BAR;
        E(acc, cur, wr, wc, fr, fq);
        if (!has_next) break;
        if (!nxt.keep) {
#pragma unroll
            for (int a = 0; a < 2; ++a)
#pragma unroll
                for (int b = 0; b < 2; ++b)
#pragma unroll
                    for (int m = 0; m < 4; ++m)
#pragma unroll
                        for (int n = 0; n < 2; ++n) acc[a][b][m][n] = (f32x4){0.f, 0.f, 0.f, 0.f};
        }
        cur = nxt; cA = nA; cB = nB; ++ui;
#pragma unroll
        for (int h = 0; h < 2; ++h)
#pragma unroll
            for (int i = 0; i < 2; ++i) { vA[h][i] = nvA[h][i]; vB[h][i] = nvB[h][i]; }
        if (wr == 1) PG8_BAR;
    }
    PG8_WAIT_V(0);
    PG8_BAR;
#undef PG8_SA
#undef PG8_SB
#undef PG8_STAGE
#undef PG8_LDA
#undef PG8_LDB
#undef PG8_MMA
#undef PG8_WAIT_V
#undef PG8_WAIT_L
#undef PG8_BAR
#undef PG8_SCHED
}
struct SchedGrid {
    const char* A; const char* B; unsigned lda, ldb; int nt, nM, nN, G, c;
    __device__ __forceinline__ bool next(int i, Unit& u) const {
        const int L = i * G + c; if (L >= nM * nN) return false;
        int pm, pn; tile_of(L, nM, nN, pm, pn);
        u.A = A + (size_t)pm * BM * lda; u.B = B + (size_t)pn * BM * ldb; u.lda = lda; u.ldb = ldb; u.nt = nt; u.keep = 0; u.pm = pm; u.pn = pn; u.x0 = 0; u.x1 = 0; u.gat = 0; u.rows = nullptr; return true;
    }
};
struct SchedMixed {
    const char *Y, *WE, *AT, *WA; int G, c;
    __device__ __forceinline__ bool next(int i, Unit& u) const {
        const int L = (i >> 1) * G + c; if (L >= (NX / BM) * (DM / BM)) return false;
        int pm, pn; tile_of(L, NX / BM, DM / BM, pm, pn);
        u.pm = pm; u.pn = pn; u.x0 = 0; u.gat = 0; u.rows = nullptr;
        if ((i & 1) == 0) { u.A = Y + (size_t)pm * BM * (PW * 2); u.B = WE + (size_t)pn * BM * (PW * 2); u.lda = PW * 2; u.ldb = PW * 2; u.nt = PW / BK; u.keep = 0; u.x1 = 0; }
        else { u.A = AT + (size_t)pm * BM * (DM * 2); u.B = WA + (size_t)pn * BM * (DM * 2); u.lda = DM * 2; u.ldb = DM * 2; u.nt = DM / BK; u.keep = 1; u.x1 = 1; }
        return true;
    }
};
struct SchedMoE {
    const unsigned* cnt; const int* list; const char* A; const char* B; unsigned lda, ldb; int nt, gather, G, vc; size_t bstride;
    __device__ __forceinline__ bool next(int i, Unit& u) const {
        const int L = i * G + vc; int rt = L >> 2; const int ct = L & 3; int off = 0;
        for (int e = 0; e < NE; ++e) {
            const int n = (int)cnt[e], tiles = (n + BM - 1) >> 8;
            if (rt < tiles) {
                u.rows = list + (size_t)e * NX + rt * BM; u.x0 = (n - rt * BM) < BM ? (n - rt * BM) : BM; u.x1 = 0; u.gat = gather;
                u.pm = off + rt * BM; u.pn = ct; u.lda = lda; u.ldb = ldb; u.nt = nt; u.keep = 0;
                u.A = gather ? A : A + (size_t)(off + rt * BM) * lda; u.B = B + (size_t)e * bstride + (size_t)ct * BM * ldb; return true;
            }
            rt -= tiles; off += n;
        }
        return false;
    }
};
struct EpiZ8 {
    const float* rope; const float* b_gate; h16 *Q, *K, *V, *U, *G0, *R;
    __device__ __forceinline__ void operator()(f32x4 (&acc)[2][2][4][2], const Unit& u, int wr, int wc, int fr, int fq) const {
        const int sec = u.pn;
#pragma unroll
        for (int bj = 0; bj < 2; ++bj) {
            const int colt = u.pn * BM + bj * HALF + wc * 32 + 8 * fq;
            f32x4 bg0 = {0.f, 0.f, 0.f, 0.f}, bg1 = {0.f, 0.f, 0.f, 0.f};
            if (sec >= 14) { const int j0 = (colt - O_G) >> 1; bg0 = *(const f32x4*)(b_gate + j0); bg1 = *(const f32x4*)(b_gate + DM + j0); }
#pragma unroll
            for (int ai = 0; ai < 2; ++ai)
#pragma unroll
                for (int m = 0; m < 4; ++m) {
                    const int row = u.pm * BM + ai * HALF + wr * 64 + m * 16 + fr;
                    const f32x4 v0 = acc[ai][bj][m][0], v1 = acc[ai][bj][m][1];
                    if (sec < 8) {
                        const int t = pos_of_row(row), i0 = (colt & 63) >> 1;
                        const f32x4 c0 = *(const f32x4*)(rope + ((size_t)t * 32 + i0) * 2), c1 = *(const f32x4*)(rope + ((size_t)t * 32 + i0 + 2) * 2);
                        float o0 = v0.x * c0.x - v0.y * c0.y, o1 = v0.y * c0.x + v0.x * c0.y, o2 = v0.z * c0.z - v0.w * c0.w, o3 = v0.w * c0.z + v0.z * c0.w;
                        float o4 = v1.x * c1.x - v1.y * c1.y, o5 = v1.y * c1.x + v1.x * c1.y, o6 = v1.z * c1.z - v1.w * c1.w, o7 = v1.w * c1.z + v1.z * c1.w;
                        if (sec < 4) { o0 *= C2; o1 *= C2; o2 *= C2; o3 *= C2; o4 *= C2; o5 *= C2; o6 *= C2; o7 *= C2; }
                        h16* dst = (sec < 4 ? Q : K) + (size_t)row * DM + (colt & (DM - 1));
                        *(u32x4*)dst = (u32x4){pk2(o0, o1), pk2(o2, o3), pk2(o4, o5), pk2(o6, o7)};
                    } else if (sec < 12) {
                        *(u32x4*)(V + (size_t)row * DM + (colt - O_V)) = (u32x4){pk2(v0.x, v0.y), pk2(v0.z, v0.w), pk2(v1.x, v1.y), pk2(v1.z, v1.w)};
                    } else if (sec < 14) {
                        *(u32x4*)(U + (size_t)row * PW + (colt - O_P)) = (u32x4){pk2(v0.x, v0.y), pk2(v0.z, v0.w), pk2(v1.x, v1.y), pk2(v1.z, v1.w)};
                    } else if (row < NX) {
                        const int j0 = (colt - O_G) >> 1;
                        const float e0 = __expf(-(v0.x + bg0.x)), f0 = __expf(-(v0.y + bg1.x)), e1 = __expf(-(v0.z + bg0.y)), f1 = __expf(-(v0.w + bg1.y));
                        const float e2 = __expf(-(v1.x + bg0.z)), f2 = __expf(-(v1.y + bg1.z)), e3 = __expf(-(v1.z + bg0.w)), f3 = __expf(-(v1.w + bg1.w));
                        *(u32x2*)(G0 + (size_t)row * DM + j0) = (u32x2){pk2(1.f / (1.f + e0), 1.f / (1.f + e1)), pk2(1.f / (1.f + e2), 1.f / (1.f + e3))};
                        *(u32x2*)(R + (size_t)row * DM + j0) = (u32x2){pk2((1.f + e0) / (1.f + f0), (1.f + e1) / (1.f + f1)), pk2((1.f + e2) / (1.f + f2), (1.f + e3) / (1.f + f3))};
                    }
                }
        }
    }
};
struct EpiMixed {
    const h16* G0; const h16* R; h16* MX;
    __device__ __forceinline__ void operator()(f32x4 (&acc)[2][2][4][2], const Unit& u, int wr, int wc, int fr, int fq) const {
#pragma unroll
        for (int ai = 0; ai < 2; ++ai)
#pragma unroll
            for (int m = 0; m < 4; ++m)
#pragma unroll
                for (int bj = 0; bj < 2; ++bj) {
                    const size_t o = (size_t)(u.pm * BM + ai * HALF + wr * 64 + m * 16 + fr) * DM + u.pn * BM + bj * HALF + wc * 32 + 8 * fq;
                    if (u.x1 == 0) { const h16x8 r = *(const h16x8*)(R + o);
                        acc[ai][bj][m][0] *= (f32x4){(float)r[0], (float)r[1], (float)r[2], (float)r[3]}; acc[ai][bj][m][1] *= (f32x4){(float)r[4], (float)r[5], (float)r[6], (float)r[7]};
                    } else { const h16x8 g = *(const h16x8*)(G0 + o); const f32x4 v0 = acc[ai][bj][m][0], v1 = acc[ai][bj][m][1];
                        *(u32x4*)(MX + o) = (u32x4){pk2(v0.x * (float)g[0], v0.y * (float)g[1]), pk2(v0.z * (float)g[2], v0.w * (float)g[3]), pk2(v1.x * (float)g[4], v1.y * (float)g[5]), pk2(v1.z * (float)g[6], v1.w * (float)g[7])}; }
                }
    }
};
struct EpiH1 {
    const float* x; float* out;
    __device__ __forceinline__ void operator()(f32x4 (&acc)[2][2][4][2], const Unit& u, int wr, int wc, int fr, int fq) const {
#pragma unroll
        for (int ai = 0; ai < 2; ++ai)
#pragma unroll
            for (int m = 0; m < 4; ++m)
#pragma unroll
                for (int bj = 0; bj < 2; ++bj)
#pragma unroll
                    for (int n = 0; n < 2; ++n) {
                        const size_t o = (size_t)(u.pm * BM + ai * HALF + wr * 64 + m * 16 + fr) * DM + u.pn * BM + bj * HALF + wc * 32 + 16 * n + 4 * fq;
                        *(f32x4*)(out + o) = *(const f32x4*)(x + o) + acc[ai][bj][m][n]; }
    }
};
struct EpiAct {
    h16* ACT;
    __device__ __forceinline__ void operator()(f32x4 (&acc)[2][2][4][2], const Unit& u, int wr, int wc, int fr, int fq) const {
#pragma unroll
        for (int ai = 0; ai < 2; ++ai)
#pragma unroll
            for (int m = 0; m < 4; ++m) {
                const int rr = ai * HALF + wr * 64 + m * 16 + fr;
                if (rr < u.x0) {
#pragma unroll
                    for (int bj = 0; bj < 2; ++bj) { const f32x4 v0 = acc[ai][bj][m][0], v1 = acc[ai][bj][m][1];
                        const float a0 = v0.x / (1.f + __expf(-v0.x)) * v0.y, a1 = v0.z / (1.f + __expf(-v0.z)) * v0.w, a2 = v1.x / (1.f + __expf(-v1.x)) * v1.y, a3 = v1.z / (1.f + __expf(-v1.z)) * v1.w;
                        *(u32x2*)(ACT + (size_t)(u.pm + rr) * DE + ((u.pn * BM + bj * HALF + wc * 32 + 8 * fq) >> 1)) = (u32x2){pk2(a0, a1), pk2(a2, a3)}; }
                }
            }
    }
};
struct EpiYE {
    h16* YE; const float* tokw;
    __device__ __forceinline__ void operator()(f32x4 (&acc)[2][2][4][2], const Unit& u, int wr, int wc, int fr, int fq) const {
#pragma unroll
        for (int ai = 0; ai < 2; ++ai)
#pragma unroll
            for (int m = 0; m < 4; ++m) {
                const int rr = ai * HALF + wr * 64 + m * 16 + fr;
                if (rr < u.x0) { const int ts = u.rows[rr]; const float w = tokw[ts];
#pragma unroll
                    for (int bj = 0; bj < 2; ++bj) { const f32x4 v0 = acc[ai][bj][m][0] * w, v1 = acc[ai][bj][m][1] * w;
                        *(u32x4*)(YE + (size_t)ts * DM + u.pn * BM + bj * HALF + wc * 32 + 8 * fq) = (u32x4){pk2(v0.x, v0.y), pk2(v0.z, v0.w), pk2(v1.x, v1.y), pk2(v1.z, v1.w)}; }
                }
            }
    }
};
}
__device__ __forceinline__ int xcd_vc(int G, int bx) { return (G % 8 == 0) ? (bx % 8) * (G / 8) + bx / 8 : bx; }
__device__ __forceinline__ void gp1_zgemm(const Params& P, PG8_LAS unsigned char* lds) {
    unsigned char* ws = P.ws;
    pg8::SchedGrid S{(const char*)(ws + WS_RA), (const char*)(ws + WS_WIN), DM * 2, DM * 2, DM / 64, MROWS / 256, IN_W / 256, (int)gridDim.x, (int)blockIdx.x};
    pg8::EpiZ8 E{(const float*)(ws + WS_ROPE), P.b_gate, (h16*)(ws + WS_RB), (h16*)(ws + WS_RC), (h16*)(ws + WS_RD), (h16*)(ws + WS_RE), (h16*)(ws + WS_RG), (h16*)(ws + WS_RG + 32 * MiB)};
    pg8::gemm_phase<true>(lds, S, E);
}
__device__ __forceinline__ void gp3a_mixed(const Params& P, PG8_LAS unsigned char* lds) {
    unsigned char* ws = P.ws;
    pg8::SchedMixed S{(const char*)(ws + WS_RF), (const char*)(ws + WS_WEFF), (const char*)(ws + WS_RB), (const char*)(ws + WS_WA), (int)gridDim.x, (int)blockIdx.x};
    pg8::EpiMixed E{(const h16*)(ws + WS_RG), (const h16*)(ws + WS_RG + 32 * MiB), (h16*)(ws + WS_RA)};
    pg8::gemm_phase<true>(lds, S, E);
}
__device__ __forceinline__ void gp3b_h1(const Params& P, PG8_LAS unsigned char* lds) {
    unsigned char* ws = P.ws;
    pg8::SchedGrid S{(const char*)(ws + WS_RA), (const char*)(ws + WS_WOUT), DM * 2, DM * 2, DM / 64, NX / 256, DM / 256, (int)gridDim.x, (int)blockIdx.x};
    pg8::EpiH1 E{P.x, P.out};
    pg8::gemm_phase<false>(lds, S, E);
}
__device__ __forceinline__ void gp4_moe1(const Params& P, PG8_LAS unsigned char* lds) {
    unsigned char* ws = P.ws;
    pg8::SchedMoE S{(const unsigned*)(ws + WS_CTL) + CW_CNT, (const int*)(ws + WS_LIST), (const char*)(ws + WS_RB), (const char*)(ws + WS_RD), DM * 2, DM * 2, DM / 64, 1, (int)gridDim.x, xcd_vc((int)gridDim.x, (int)blockIdx.x), (size_t)(2 * DE) * DM * 2};
    pg8::EpiAct E{(h16*)(ws + WS_RA)};
    pg8::gemm_phase<true>(lds, S, E);
}
__device__ __forceinline__ void gp5_moe2(const Params& P, PG8_LAS unsigned char* lds) {
    unsigned char* ws = P.ws;
    pg8::SchedMoE S{(const unsigned*)(ws + WS_CTL) + CW_CNT, (const int*)(ws + WS_LIST), (const char*)(ws + WS_RA), (const char*)(ws + WS_RC), DE * 2, DE * 2, DE / 64, 0, (int)gridDim.x, xcd_vc((int)gridDim.x, (int)blockIdx.x), (size_t)DM * DE * 2};
    pg8::EpiYE E{(h16*)(ws + WS_RG), (const float*)(ws + WS_TOKW)};
    pg8::gemm_phase<true>(lds, S, E);
}

namespace att {
typedef float f32x16 __attribute__((ext_vector_type(16)));
typedef short s16x4 __attribute__((ext_vector_type(4)));
typedef __attribute__((address_space(3))) unsigned char* lptr;
constexpr int SLOT_K = 8192, SLOT_V = 16384, NSLOT = 3;
constexpr int L_K = 0, L_V = NSLOT * SLOT_K, L_WS = L_V + NSLOT * SLOT_V, L_OST = L_WS + 8 * 256, L_END = L_OST + 8 * 8192;
constexpr float THR = 8.f;
__device__ __forceinline__ int crow(int r, int hi) { return (r & 3) + 8 * (r >> 2) + 4 * hi; }
__device__ __forceinline__ void glds16(const void* gsrc, unsigned lds_dst) { unsigned keep;
    asm volatile("s_mov_b32 %0, m0\n\ts_mov_b32 m0, %2\n\ts_nop 0\n\tglobal_load_lds_dwordx4 %1, off\n\ts_mov_b32 m0, %0" : "=&s"(keep) : "v"(gsrc), "s"(lds_dst) : "memory"); }
#define ATT_WAIT_BAR(N) asm volatile("s_waitcnt vmcnt(" #N ") lgkmcnt(0)\n\ts_barrier" ::: "memory")
__device__ __forceinline__ h16x4 vtr(lptr p) { return __builtin_bit_cast(h16x4, __builtin_amdgcn_ds_read_tr16_b64_v4i16((__attribute__((address_space(3))) s16x4*)p)); }
__device__ __forceinline__ void attn_unit(int b, int h, int qb, const h16* Qb, const h16* Kb, const h16* Vb, h16* Ab, const float* subln_g, float lam, lptr shm) {
    const int tid = threadIdx.x, lane = tid & 63, r32 = lane & 31, hi = lane >> 5; const int wid = __builtin_amdgcn_readfirstlane(tid >> 6);
    const unsigned lds0 = (unsigned)(uintptr_t)shm;
    __attribute__((address_space(3))) float* wsf = (__attribute__((address_space(3))) float*)(shm + L_WS) + wid * 64;
    __attribute__((address_space(3))) h16* stg = (__attribute__((address_space(3))) h16*)(shm + L_OST) + wid * 4096;
    const int NT = 4 * (qb + 1) + 1;
    const int qi = 256 * qb + 32 * wid + r32;
    const size_t qrow = (size_t)b * SEQ + qi;
    const h16* Vh = Vb + h * 128;
    const int vrow = 16 * (wid & 3) + (lane >> 2), vcol = (wid >> 2) * 32 + (lane & 3) * 8;
    for (int c = 0; c < 2; ++c) {
        const h16* Kc = Kb + h * 128 + c * 64;
#define ATT_DMA(j, slot) do { const int rb_ = (j) == 0 ? NX : b * SEQ + 64 * ((j) - 1); \
        glds16(Kc + (size_t)(rb_ + lane) * DM + wid * 8, (unsigned)__builtin_amdgcn_readfirstlane(lds0 + L_K + (slot) * SLOT_K + wid * 1024)); \
        glds16(Vh + (size_t)(rb_ + vrow) * DM + vcol, (unsigned)__builtin_amdgcn_readfirstlane(lds0 + L_V + (slot) * SLOT_V + wid * 1024)); \
        glds16(Vh + (size_t)(rb_ + vrow) * DM + 64 + vcol, (unsigned)__builtin_amdgcn_readfirstlane(lds0 + L_V + (slot) * SLOT_V + (wid + 8) * 1024)); } while (0)
        h16x8 qr[4];
#pragma unroll
        for (int d0 = 0; d0 < 4; ++d0) qr[d0] = *(const h16x8*)(Qb + qrow * DM + h * 128 + c * 64 + d0 * 16 + hi * 8);
        asm volatile("" : "+v"(qr[0]), "+v"(qr[1]), "+v"(qr[2]), "+v"(qr[3]));
        ATT_DMA(0, 0); ATT_DMA(1, 1);
        f32x16 o[4];
#pragma unroll
        for (int d = 0; d < 4; ++d)
#pragma unroll
            for (int r = 0; r < 16; ++r) o[d][r] = 0.f;
        float m = 0.f, l = 0.f; int slot = 0;
        for (int t = 0; t < NT; ++t) {
            if (t + 1 < NT) ATT_WAIT_BAR(3); else ATT_WAIT_BAR(0);
            if (t + 2 < NT) { const int s2 = slot == 0 ? 2 : slot - 1; ATT_DMA(t + 2, s2); }
            const lptr kp = shm + L_K + slot * SLOT_K + hi * 1024 + r32 * 16;
            f32x16 p0, p1;
#pragma unroll
            for (int r = 0; r < 16; ++r) { p0[r] = 0.f; p1[r] = 0.f; }
#pragma unroll
            for (int d0 = 0; d0 < 4; ++d0) {
                const h16x8 k0 = *(const __attribute__((address_space(3))) h16x8*)(kp + d0 * 2048), k1 = *(const __attribute__((address_space(3))) h16x8*)(kp + d0 * 2048 + 512);
                p0 = __builtin_amdgcn_mfma_f32_32x32x16_f16(k0, qr[d0], p0, 0, 0, 0); p1 = __builtin_amdgcn_mfma_f32_32x32x16_f16(k1, qr[d0], p1, 0, 0, 0);
            }
            if (t == 0) {
#pragma unroll
                for (int r = 0; r < 16; ++r) { if (r >= 8) p0[r] = -INFINITY; p1[r] = -INFINITY; }
            } else if (t >= NT - 4) {
                const int kb = 64 * (t - 1) + 4 * hi;
#pragma unroll
                for (int r = 0; r < 16; ++r) { const int kv = kb + (r & 3) + 8 * (r >> 2); if (kv > qi) p0[r] = -INFINITY; if (kv + 32 > qi) p1[r] = -INFINITY; }
            }
            float rm = fmaxf(p0[0], p1[0]);
#pragma unroll
            for (int r = 1; r < 16; ++r) rm = fmaxf(rm, fmaxf(p0[r], p1[r]));
            rm = fmaxf(rm, __shfl_xor(rm, 32));
            if (t == 0) m = rm;
            else {
                const float d = rm - m;
                if (__any(d > THR)) {
                    const float dl = fmaxf(d, 0.f); m += dl; const float f = __builtin_amdgcn_exp2f(-dl); l *= f;
                    if (hi == 0) wsf[r32] = f;
                    __builtin_amdgcn_s_waitcnt(0xC07F); __builtin_amdgcn_wave_barrier();
#pragma unroll
                    for (int r = 0; r < 16; ++r) { const float fr_ = wsf[crow(r, hi)];
#pragma unroll
                        for (int dd = 0; dd < 4; ++dd) o[dd][r] *= fr_; }
                    __builtin_amdgcn_wave_barrier();
                }
            }
            float sacc = 0.f;
#pragma unroll
            for (int r = 0; r < 16; ++r) { p0[r] = __builtin_amdgcn_exp2f(p0[r] - m); p1[r] = __builtin_amdgcn_exp2f(p1[r] - m); sacc += p0[r] + p1[r]; }
            l += sacc;
            u32x4 pw[4];
            pw[0] = (u32x4){pk2(p0[0], p0[1]), pk2(p0[2], p0[3]), pk2(p0[4], p0[5]), pk2(p0[6], p0[7])};
            pw[1] = (u32x4){pk2(p0[8], p0[9]), pk2(p0[10], p0[11]), pk2(p0[12], p0[13]), pk2(p0[14], p0[15])};
            pw[2] = (u32x4){pk2(p1[0], p1[1]), pk2(p1[2], p1[3]), pk2(p1[4], p1[5]), pk2(p1[6], p1[7])};
            pw[3] = (u32x4){pk2(p1[8], p1[9]), pk2(p1[10], p1[11]), pk2(p1[12], p1[13]), pk2(p1[14], p1[15])};
            const lptr vp = shm + L_V + slot * SLOT_V + ((lane >> 4) & 1) * 32 + (lane & 3) * 8 + (4 * hi + ((lane & 15) >> 2)) * 64;
#pragma unroll
            for (int db = 0; db < 4; ++db)
#pragma unroll
                for (int ks = 0; ks < 4; ++ks) {
                    const h16x4 lo = vtr(vp + db * 4096 + ks * 1024), hh = vtr(vp + db * 4096 + ks * 1024 + 512);
                    const h16x8 vf = {lo[0], lo[1], lo[2], lo[3], hh[0], hh[1], hh[2], hh[3]};
                    o[db] = __builtin_amdgcn_mfma_f32_32x32x16_f16(__builtin_bit_cast(h16x8, pw[ks]), vf, o[db], 0, 0, 0);
                }
            slot = slot == 2 ? 0 : slot + 1;
        }
        l += __shfl_xor(l, 32);
        if (hi == 0) wsf[32 + r32] = l;
        __builtin_amdgcn_s_waitcnt(0xC07F); __builtin_amdgcn_wave_barrier();
        float rli[16];
#pragma unroll
        for (int r = 0; r < 16; ++r) rli[r] = 1.0f / wsf[32 + crow(r, hi)];
        if (c == 0) {
#pragma unroll
            for (int db = 0; db < 4; ++db)
#pragma unroll
                for (int r = 0; r < 16; ++r) stg[crow(r, hi) * 128 + db * 32 + r32] = (h16)(o[db][r] * rli[r]);
        } else {
#pragma unroll
            for (int db = 0; db < 4; ++db)
#pragma unroll
                for (int r = 0; r < 16; ++r) { const int ix = crow(r, hi) * 128 + db * 32 + r32; stg[ix] = (h16)((float)stg[ix] - lam * o[db][r] * rli[r]); }
            __builtin_amdgcn_s_waitcnt(0xC07F); __builtin_amdgcn_wave_barrier();
            const int ch = lane & 7;
            const f32x4 g0 = *(const f32x4*)(subln_g + ch * 8), g1 = *(const f32x4*)(subln_g + ch * 8 + 4), g2 = *(const f32x4*)(subln_g + 64 + ch * 8), g3 = *(const f32x4*)(subln_g + 64 + ch * 8 + 4);
#pragma unroll
            for (int i = 0; i < 4; ++i) {
                const int row = i * 8 + (lane >> 3);
                const h16x8 a = *(const __attribute__((address_space(3))) h16x8*)(stg + row * 128 + ch * 8), bb = *(const __attribute__((address_space(3))) h16x8*)(stg + row * 128 + 64 + ch * 8);
                float av[8], bv[8]; float ss = 0.f;
#pragma unroll
                for (int j = 0; j < 8; ++j) { av[j] = (float)a[j]; bv[j] = (float)bb[j]; ss += av[j] * av[j] + bv[j] * bv[j]; }
                ss += __shfl_xor(ss, 1); ss += __shfl_xor(ss, 2); ss += __shfl_xor(ss, 4);
                const float rs = rsqrtf(ss * (1.f / VD) + EPS) * (1.f - LAMBDA_INIT);
                h16* dst = Ab + ((size_t)b * SEQ + 256 * qb + 32 * wid + row) * DM + h * 128 + ch * 8;
                *(u32x4*)dst = (u32x4){pk2(av[0] * rs * g0.x, av[1] * rs * g0.y), pk2(av[2] * rs * g0.z, av[3] * rs * g0.w), pk2(av[4] * rs * g1.x, av[5] * rs * g1.y), pk2(av[6] * rs * g1.z, av[7] * rs * g1.w)};
                *(u32x4*)(dst + 64) = (u32x4){pk2(bv[0] * rs * g2.x, bv[1] * rs * g2.y), pk2(bv[2] * rs * g2.z, bv[3] * rs * g2.w), pk2(bv[4] * rs * g3.x, bv[5] * rs * g3.y), pk2(bv[6] * rs * g3.z, bv[7] * rs * g3.w)};
            }
        }
        asm volatile("s_waitcnt vmcnt(0) lgkmcnt(0)\n\ts_barrier" ::: "memory");
#undef ATT_DMA
    }
}
}
__device__ __forceinline__ void gp2_attn(const Params& P, att::lptr lds) {
    unsigned char* ws = P.ws;
    const h16* Q = (const h16*)(ws + WS_RB); const h16* Kb = (const h16*)(ws + WS_RC); const h16* Vb = (const h16*)(ws + WS_RD); h16* A = (h16*)(ws + WS_RB);
    const float lam = *(const float*)(ws + WS_LAM);
    const int G = (int)gridDim.x, vcu = (G % 8 == 0) ? ((int)blockIdx.x % 8) * (G / 8) + (int)blockIdx.x / 8 : (int)blockIdx.x;
    for (int u = vcu; u < NB * NH * 4; u += G) {
        const int bh = u >> 2, s = u & 3;
        att::attn_unit(bh >> 3, bh & 7, s, Q, Kb, Vb, A, P.subln_g, lam, lds);
        att::attn_unit(bh >> 3, bh & 7, 7 - s, Q, Kb, Vb, A, P.subln_g, lam, lds);
    }
}

#define LAS __attribute__((address_space(3)))
#define XB_TMO      128
#define XB_XCNT(j)  (256  + 64 * (j))
#define XB_XSUB(j)  (1280 + 64 * (j))
#define XB_XGEN(j)  (2304 + 64 * (j))
#define XB_TOP      3328
#define XB_TOPGEN   3392
#define XCD_BAR_WORDS 3456
#define XB_SPIN_CAP (1u << 18)
constexpr int CW_BAR = 4096;
static_assert((CW_BAR + XCD_BAR_WORDS) * 4 <= (int)CTL_BYTES, "barrier words inside the memset region");
__device__ __forceinline__ unsigned xb_ld(unsigned* p)              { return __hip_atomic_load(p, __ATOMIC_RELAXED, __HIP_MEMORY_SCOPE_AGENT); }
__device__ __forceinline__ unsigned xb_add(unsigned* p, unsigned v) { return __hip_atomic_fetch_add(p, v, __ATOMIC_RELAXED, __HIP_MEMORY_SCOPE_AGENT); }
__device__ __forceinline__ unsigned xb_xcc_id() { return (unsigned)__builtin_amdgcn_s_getreg((3 << 11) | 20) & 0xFu; }
#define XB_SPIN(cond, bar) do { unsigned _sp = 0; while (cond) { __builtin_amdgcn_s_sleep(1); \
    if ((++_sp & 255u) == 0u) { if (xb_ld(&(bar)[XB_TMO])) break; if (_sp > XB_SPIN_CAP) { atomicAdd(&(bar)[XB_TMO], 1u); break; } } } } while (0)
struct XcdBarrier { unsigned* bar; unsigned x; volatile LAS unsigned* st; };
__device__ __forceinline__ XcdBarrier xcd_barrier_post(unsigned* bar, volatile LAS unsigned* st) {
    XcdBarrier b; b.bar = bar; b.x = xb_xcc_id(); b.st = st;
    if (threadIdx.x == 0) (void)xb_add(&bar[XB_XCNT(b.x)], 1u);
    return b;
}
__device__ __forceinline__ void xcd_barrier_complete(unsigned* bar, unsigned x, unsigned& nloc, unsigned& nx) {
    const unsigned G = gridDim.x * gridDim.y * gridDim.z;
    unsigned sum, cnt, mine, sp = 0u;
    for (;;) {
        sum = 0u; cnt = 0u; mine = 0u;
#pragma unroll
        for (unsigned j = 0; j < 16; ++j) { const unsigned c = xb_ld(&bar[XB_XCNT(j)]); sum += c; cnt += (c > 0u) ? 1u : 0u; mine = (j == x) ? c : mine; }
        if (sum == G) break;
        __builtin_amdgcn_s_sleep(1);
        if ((++sp & 255u) == 0u) { if (xb_ld(&bar[XB_TMO])) break; if (sp > XB_SPIN_CAP) { atomicAdd(&bar[XB_TMO], 1u); break; } }
    }
    nloc = mine > 0u ? mine : 1u; nx = cnt > 0u ? cnt : 1u;
}
__device__ __forceinline__ void xcd_barrier(const XcdBarrier& b) {
    asm volatile("s_waitcnt vmcnt(0)" ::: "memory");
    __syncthreads();
    if (threadIdx.x == 0) {
        unsigned* bar = b.bar;
        __builtin_amdgcn_s_waitcnt(0);
        unsigned nloc = b.st[0], nx = b.st[1];
        if (nloc == 0u) { xcd_barrier_complete(bar, b.x, nloc, nx); b.st[0] = nloc; b.st[1] = nx; }
        const unsigned old = xb_add(&bar[XB_XSUB(b.x)], 1u);
        const unsigned gen = old / nloc;
        if (old + 1u == (gen + 1u) * nloc) {
            __builtin_amdgcn_fence(__ATOMIC_RELEASE, "agent");
            asm volatile("s_waitcnt vmcnt(0)" ::: "memory");
            const unsigned og = xb_add(&bar[XB_TOP], 1u);
            const unsigned tg = og / nx;
            if (og + 1u == (tg + 1u) * nx) xb_add(&bar[XB_TOPGEN], 1u);
            else XB_SPIN(xb_ld(&bar[XB_TOPGEN]) == tg, bar);
            __builtin_amdgcn_fence(__ATOMIC_ACQUIRE, "agent");
            xb_add(&bar[XB_XGEN(b.x)], 1u);
            asm volatile("s_waitcnt vmcnt(0)" ::: "memory");
        } else {
            XB_SPIN(xb_ld(&bar[XB_XGEN(b.x)]) == gen, bar);
            __builtin_amdgcn_fence(__ATOMIC_ACQUIRE, "agent");
            asm volatile("s_waitcnt vmcnt(0)" ::: "memory");
        }
    }
    __syncthreads();
}

constexpr int NWAVES = 8, LDS_BYTES = 155648, MISC_OFF = 153600;
constexpr int N_PHASES = 12;
struct Args { Params P; int ph_lo, ph_hi, use_cg, pad; };
__global__ void __launch_bounds__(NWAVES * 64, 2) mk_fwd(Args a) {
    extern __shared__ __attribute__((aligned(16))) unsigned char lds_raw[];
    float* lds = (float*)lds_raw;
    volatile LAS unsigned* MISC = (volatile LAS unsigned*)((LAS unsigned char*)lds_raw + MISC_OFF);
    if (threadIdx.x < 32) MISC[threadIdx.x] = 0u;
    __syncthreads();
    const bool one = (a.ph_hi - a.ph_lo) > 1;
    XcdBarrier bar; bar.bar = (unsigned*)(a.P.ws + WS_CTL) + CW_BAR; bar.x = 0; bar.st = nullptr;
    if (one) bar = xcd_barrier_post((unsigned*)(a.P.ws + WS_CTL) + CW_BAR, MISC + 8);
    if (a.use_cg) cooperative_groups::this_grid().sync();
    const Params& P = a.P;
    PG8_LAS unsigned char* L3 = (PG8_LAS unsigned char*)lds_raw;
#define PHASE(k, body) if (a.ph_lo <= (k) && (k) < a.ph_hi) { body; if ((k) + 1 < a.ph_hi) xcd_barrier(bar); }
    PHASE(0, ph0_prologue(P, lds))
    PHASE(1, gp1_zgemm(P, L3))
    PHASE(2, gp2_attn(P, (att::lptr)lds_raw))
    PHASE(3, ph2_pool(P))
    PHASE(4, ph2b_moew(P, lds))
    PHASE(5, gp3a_mixed(P, L3))
    PHASE(6, (void)0)
    PHASE(7, gp3b_h1(P, L3))
    PHASE(8, ph3c_route(P))
    PHASE(9, gp4_moe1(P, L3))
    PHASE(10, gp5_moe2(P, L3))
    PHASE(11, ph6_final(P))
#undef PHASE
}

#ifndef MK_N_LAUNCHES
#define MK_N_LAUNCHES 1
#endif
extern "C" void kernel_launch(void* const* d_in, const int* in_sizes, int n_in, void* d_out, int out_size, void* d_ws, size_t ws_size, hipStream_t stream) {
    static int grid = 0;
    if (grid == 0) {
        if (n_in != 24 || in_sizes[0] != NX * DM || out_size != NX * DM || ws_size < WS_END) {
            fprintf(stderr, "kernel_launch: unexpected shapes (n_in %d, in0 %d, out %d, ws %zu); nothing launched\n", n_in, n_in > 0 ? in_sizes[0] : -1, out_size, ws_size); grid = -1; return; }
        int dev = 0, cus = 0, per_cu = 0;
        if (hipGetDevice(&dev) != hipSuccess || hipDeviceGetAttribute(&cus, hipDeviceAttributeMultiprocessorCount, dev) != hipSuccess) { grid = -1; return; }
        if (hipFuncSetAttribute((const void*)mk_fwd, hipFuncAttributeMaxDynamicSharedMemorySize, LDS_BYTES) != hipSuccess) { fprintf(stderr, "kernel_launch: hipFuncSetAttribute failed\n"); grid = -1; return; }
        if (hipOccupancyMaxActiveBlocksPerMultiprocessor(&per_cu, (const void*)mk_fwd, NWAVES * 64, LDS_BYTES) != hipSuccess || per_cu < 1) { fprintf(stderr, "kernel_launch: occupancy query says %d blocks per CU\n", per_cu); (void)hipGetLastError(); grid = -1; return; }
        grid = cus;
    }
    if (grid < 0) return;
    (void)hipMemsetAsync((char*)d_ws + WS_CTL, 0, CTL_BYTES, stream);
    Args a{};
    const float** pp = (const float**)&a.P;
    for (int i = 0; i < 24; ++i) pp[i] = (const float*)d_in[i];
    a.P.out = (float*)d_out; a.P.ws = (unsigned char*)d_ws;
    if (MK_N_LAUNCHES == 1) {
        a.ph_lo = 0; a.ph_hi = N_PHASES;
        void* args[] = {&a};
        hipError_t e = hipLaunchCooperativeKernel((const void*)mk_fwd, dim3(grid), dim3(NWAVES * 64), args, LDS_BYTES, stream);
        if (e != hipSuccess) fprintf(stderr, "kernel_launch: cooperative launch failed: %s (grid %d)\n", hipGetErrorString(e), grid);
    } else {
        for (int k = 0; k < N_PHASES; ++k) { a.ph_lo = k; a.ph_hi = k + 1; hipLaunchKernelGGL(mk_fwd, dim3(grid), dim3(NWAVES * 64), LDS_BYTES, stream, a); }
    }
}
```

```cpp
#include <hip/hip_runtime.h>
#include <hip/hip_cooperative_groups.h>
#include <cstdio>
#include <cstdint>

typedef _Float16 h16;
typedef _Float16 h16x2 __attribute__((ext_vector_type(2)));
typedef _Float16 h16x4 __attribute__((ext_vector_type(4)));
typedef _Float16 h16x8 __attribute__((ext_vector_type(8)));
typedef float f32x2 __attribute__((ext_vector_type(2)));
typedef float f32x4 __attribute__((ext_vector_type(4)));
typedef unsigned u32x2 __attribute__((ext_vector_type(2)));
typedef unsigned u32x4 __attribute__((ext_vector_type(4)));

constexpr int NB = 8, SEQ = 2048, NMETA = 16, TT = SEQ + NMETA, DM = 1024;
constexpr int NX = NB * SEQ;
constexpr int MROWS = 16640;
constexpr int NH = 8, HD = 64, VD = 128;
constexpr int IN_W = 5632, O_K = 1024, O_V = 2048, O_P = 3072, O_G = 3584, PW = 512;
constexpr int NE = 16, DE = 512;
constexpr float EPS = 1e-6f;
constexpr float C2 = 0.125f * 1.4426950408889634f;
constexpr float LAMBDA_INIT = 0.2f;

constexpr size_t MiB = 1u << 20;
constexpr size_t WS_CTL = 0, CTL_BYTES = 1 * MiB;
constexpr size_t WS_ROPE = 1 * MiB;
constexpr size_t WS_LAM = 1 * MiB + 768 * 1024;
constexpr size_t WS_TOKW = 2 * MiB;
constexpr size_t WS_LIST = 3 * MiB;
constexpr size_t WS_WIN = 4 * MiB;
constexpr size_t WS_WA = 15 * MiB;
constexpr size_t WS_WEFF = 17 * MiB;
constexpr size_t WS_WOUT = 18 * MiB;
constexpr size_t WS_RA = 20 * MiB;
constexpr size_t WS_RB = WS_RA + 33 * MiB - MiB / 2;
constexpr size_t WS_RC = WS_RB + 33 * MiB - MiB / 2;
constexpr size_t WS_RD = WS_RC + 33 * MiB - MiB / 2;
constexpr size_t WS_RE = WS_RD + 33 * MiB - MiB / 2;
constexpr size_t WS_RF = WS_RE + 16 * MiB + MiB / 4;
constexpr size_t WS_RG = WS_RF + 16 * MiB;
constexpr size_t WS_END = WS_RG + 64 * MiB;
static_assert(WS_END <= 256 * MiB, "workspace map");
constexpr int CW_CNT = 64;

struct Params {
    const float *x, *meta, *norm1_g, *w_in, *b_gate, *lq1, *lk1, *lq2, *lk2, *subln_g, *pool_w, *pool_scale, *w_attn_br, *w_pool_br, *w_out, *norm2_g,
                *w_rg, *b_rg, *w_re, *b_re, *w_eg, *w_eu, *w_ed, *final_g;
    float* out; unsigned char* ws;
};

#define LAS __attribute__((address_space(3)))
__device__ __forceinline__ unsigned pk2(float a, float b) { f32x2 v = {a, b}; h16x2 h = __builtin_convertvector(v, h16x2); return __builtin_bit_cast(unsigned, h); }
__device__ __forceinline__ float wave_sum(float v) {
#pragma unroll
    for (int o = 1; o < 64; o <<= 1) v += __shfl_xor(v, o);
    return v;
}
__device__ __forceinline__ int pos_of_row(int r) { return r < NX ? NMETA + (r & (SEQ - 1)) : r - NX; }
__device__ __forceinline__ int row_of_pos(int b, int p) { return p < NMETA ? NX + p : b * SEQ + p - NMETA; }
__device__ __forceinline__ void lds_fence() { __builtin_amdgcn_s_waitcnt(0xC07F); __builtin_amdgcn_wave_barrier(); }

__device__ __forceinline__ void transpose_tile(const float* pa, const float* pb, size_t ldw, bool ilv, h16* dst, size_t ldk, LAS float* scr, int lane) {
    const int sub = lane >> 4, cq = lane & 15;
    const float* src = (cq < 8 ? pa + 4 * cq : pb + 4 * (cq - 8)) + (size_t)sub * ldw;
    f32x4 v[16];
#pragma unroll
    for (int i = 0; i < 16; ++i) v[i] = *(const f32x4*)(src + (size_t)(4 * i) * ldw);
    const int c0 = 4 * cq, nbase = ilv ? (c0 & 31) * 2 + (c0 >> 5) : c0, nstep = ilv ? 2 : 1;
    LAS float* w = scr + sub * 65 + nbase;
#pragma unroll
    for (int i = 0; i < 16; ++i) { w[(4 * i) * 65] = v[i].x; w[(4 * i) * 65 + nstep] = v[i].y; w[(4 * i) * 65 + 2 * nstep] = v[i].z; w[(4 * i) * 65 + 3 * nstep] = v[i].w; }
    lds_fence();
    const int kc = lane & 7, nb = lane >> 3;
#pragma unroll
    for (int j = 0; j < 8; ++j) { const int n = nb + 8 * j; const LAS float* sp = scr + (8 * kc) * 65 + n;
        u32x4 o; o.x = pk2(sp[0], sp[65]); o.y = pk2(sp[2 * 65], sp[3 * 65]); o.z = pk2(sp[4 * 65], sp[5 * 65]); o.w = pk2(sp[6 * 65], sp[7 * 65]);
        *(u32x4*)(dst + (size_t)n * ldk + 8 * kc) = o; }
    lds_fence();
}
__device__ __forceinline__ void hn_row(const Params& P, h16* HN, int r, int lane) {
    u32x2* o = (u32x2*)(HN + (size_t)r * DM) + lane;
    if (r >= NX + NMETA) {
#pragma unroll
        for (int j = 0; j < 4; ++j) o[64 * j] = (u32x2){0u, 0u};
        return;
    }
    const float* src = r < NX ? P.x + (size_t)r * DM : P.meta + (size_t)(r - NX) * DM;
    const f32x4* xr = (const f32x4*)src + lane;
    f32x4 v[4]; float s = 0.f;
#pragma unroll
    for (int j = 0; j < 4; ++j) { v[j] = xr[64 * j]; s += (v[j].x * v[j].x + v[j].y * v[j].y) + (v[j].z * v[j].z + v[j].w * v[j].w); }
    const float rs = rsqrtf(wave_sum(s) * (1.f / DM) + EPS);
#pragma unroll
    for (int j = 0; j < 4; ++j) { const f32x4 g = ((const f32x4*)P.norm1_g)[lane + 64 * j];
        o[64 * j] = (u32x2){pk2(v[j].x * rs * g.x, v[j].y * rs * g.y), pk2(v[j].z * rs * g.z, v[j].w * rs * g.w)}; }
}
__device__ __forceinline__ void ph0_prologue(const Params& P, LAS unsigned char* lds) {
    const int tid = threadIdx.x, lane = tid & 63, wave = tid >> 6, nw = blockDim.x >> 6;
    const int gw = blockIdx.x * nw + wave, NGW = gridDim.x * nw;
    const int gt = blockIdx.x * blockDim.x + tid, NGT = gridDim.x * blockDim.x;
    unsigned char* ws = P.ws;
    LAS float* scr = (LAS float*)lds + wave * (64 * 65);
    {
        h16* WguT = (h16*)P.out; h16* WdnT = (h16*)((unsigned char*)P.out + 32 * MiB);
        for (int it = gw; it < NE * 16 * 16; it += NGW) { const int e = it >> 8, kt = (it >> 4) & 15, nt = it & 15; const size_t so = (size_t)e * DM * DE + (size_t)(64 * kt) * DE + 32 * nt;
            transpose_tile(P.w_eg + so, P.w_eu + so, DE, true, WguT + ((size_t)e * 1024 + 64 * nt) * DM + 64 * kt, DM, scr, lane); }
        for (int it = gw; it < NE * 8 * 16; it += NGW) { const int e = it >> 7, kt = (it >> 4) & 7, nt = it & 15; const float* pa = P.w_ed + (size_t)e * DE * DM + (size_t)(64 * kt) * DM + 64 * nt;
            transpose_tile(pa, pa + 32, DM, false, WdnT + ((size_t)e * 1024 + 64 * nt) * DE + 64 * kt, DE, scr, lane); }
    }
    {
        h16* WinT = (h16*)(ws + WS_WIN);
        for (int it = gw; it < 16 * 88; it += NGW) { const int kt = it / 88, nt = it % 88; const float* rowp = P.w_in + (size_t)(64 * kt) * IN_W;
            const float* pa = nt < 56 ? rowp + 64 * nt : rowp + O_G + 32 * (nt - 56); const float* pb = nt < 56 ? pa + 32 : pa + DM;
            transpose_tile(pa, pb, IN_W, nt < 32 || nt >= 56, WinT + (size_t)(64 * nt) * DM + 64 * kt, DM, scr, lane); }
        h16* WaT = (h16*)(ws + WS_WA); h16* WoT = (h16*)(ws + WS_WOUT);
        for (int it = gw; it < 512; it += NGW) { const int which = it >> 8, kt = (it >> 4) & 15, nt = it & 15; const float* pa = (which ? P.w_out : P.w_attn_br) + (size_t)(64 * kt) * DM + 64 * nt;
            transpose_tile(pa, pa + 32, DM, false, (which ? WoT : WaT) + (size_t)(64 * nt) * DM + 64 * kt, DM, scr, lane); }
    }
    float* rope = (float*)(ws + WS_ROPE);
    for (int it = gt; it < TT * 32; it += NGT) {
        const int t = it >> 5, i = it & 31;
        const float inv = 1.0f / powf(10000.0f, (float)(2 * i) / 64.0f);
        const float ang = (float)t * inv;
        rope[2 * it] = (float)cos((double)ang); rope[2 * it + 1] = (float)sin((double)ang);
    }
    if (gt == 0) {
        float s1 = 0.f, s2 = 0.f;
        for (int i = 0; i < HD; ++i) { s1 += P.lq1[i] * P.lk1[i]; s2 += P.lq2[i] * P.lk2[i]; }
        *(float*)(ws + WS_LAM) = expf(s1) - expf(s2) + LAMBDA_INIT;
    }
    {
        h16* WeT = (h16*)(ws + WS_WEFF);
        for (int it = gw; it < 4 * 16 * 16; it += NGW) {
            const int nb = it & 15, c8 = (it >> 4) & 15, g = it >> 8, n = nb * 64 + lane;
            float acc[8];
#pragma unroll
            for (int j = 0; j < 8; ++j) acc[j] = 0.f;
#pragma unroll 4
            for (int d = 0; d < 128; ++d) {
                const float wv = P.w_pool_br[(size_t)(g * 128 + d) * DM + n] * P.pool_scale[g * 128 + d];
#pragma unroll
                for (int j = 0; j < 8; ++j) acc[j] += P.pool_w[((size_t)g * 128 + c8 * 8 + j) * 128 + d] * wv;
            }
            u32x4 o; o.x = pk2(acc[0], acc[1]); o.y = pk2(acc[2], acc[3]); o.z = pk2(acc[4], acc[5]); o.w = pk2(acc[6], acc[7]);
            *(u32x4*)(WeT + (size_t)n * PW + g * 128 + c8 * 8) = o;
        }
    }
    { h16* HN = (h16*)(ws + WS_RA); for (int r = gw; r < MROWS; r += NGW) hn_row(P, HN, r, lane); }
}

template <int W>
__device__ __forceinline__ void pool_run(const h16* U, h16* Y, int b, int g, int i0, int lane) {
    f32x2 buf[31 + W];
    const int p0 = NMETA + i0 - W + 1;
#pragma unroll
    for (int q = 0; q < 31 + W; ++q) { const h16x2 u2 = *(const h16x2*)(U + (size_t)row_of_pos(b, p0 + q) * PW + g * 128 + 2 * lane); buf[q] = (f32x2){(float)u2[0], (float)u2[1]}; }
    f32x2 s = buf[0];
#pragma unroll
    for (int q = 1; q < W; ++q) s += buf[q];
    const float iw = 1.f / (float)W;
#pragma unroll
    for (int i = 0; i < 32; ++i) {
        const f32x2 o = s * iw - buf[W - 1 + i];
        *(unsigned*)(Y + ((size_t)b * SEQ + i0 + i) * PW + g * 128 + 2 * lane) = pk2(o.x, o.y);
        if (i < 31) s += buf[W + i] - buf[i];
    }
}
__device__ __forceinline__ void ph_pool(const Params& P) {
    const int tid = threadIdx.x, lane = tid & 63, wave = tid >> 6, nw = blockDim.x >> 6;
    const int gw = blockIdx.x * nw + wave, NGW = gridDim.x * nw;
    const h16* U = (const h16*)(P.ws + WS_RE); h16* Y = (h16*)(P.ws + WS_RF);
    for (int it = gw; it < NB * 4 * (SEQ / 32); it += NGW) {
        const int run = it & 63, g = __builtin_amdgcn_readfirstlane((it >> 6) & 3), b = it >> 8;
        if (g == 0) pool_run<2>(U, Y, b, 0, run * 32, lane); else if (g == 1) pool_run<4>(U, Y, b, 1, run * 32, lane);
        else if (g == 2) pool_run<8>(U, Y, b, 2, run * 32, lane); else pool_run<16>(U, Y, b, 3, run * 32, lane);
    }
}

__device__ __forceinline__ void ph_route(const Params& P, LAS unsigned char* lds) {
    const int tid = threadIdx.x, lane = tid & 63, wave = tid >> 6;
    unsigned char* ws = P.ws;
    const float* H1 = (const float*)(ws + WS_RC); h16* HN2 = (h16*)(ws + WS_RB);
    unsigned* cnt = (unsigned*)(ws + WS_CTL) + CW_CNT; int* list = (int*)(ws + WS_LIST); float* tokw = (float*)(ws + WS_TOKW);
    LAS float* WT = (LAS float*)lds;
    LAS int* lcnt = (LAS int*)(lds + 81920); LAS int* lbase = lcnt + 16; LAS int* ent = lcnt + 32;
    for (int k = tid; k < DM; k += blockDim.x) {
        const f32x4 g = *(const f32x4*)(P.w_rg + (size_t)k * 4);
        WT[0 * DM + k] = g.x; WT[1 * DM + k] = g.y; WT[2 * DM + k] = g.z; WT[3 * DM + k] = g.w;
#pragma unroll
        for (int q = 0; q < 4; ++q) { const f32x4 e4 = *(const f32x4*)(P.w_re + (size_t)k * 16 + 4 * q);
            WT[(4 + 4 * q) * DM + k] = e4.x; WT[(5 + 4 * q) * DM + k] = e4.y; WT[(6 + 4 * q) * DM + k] = e4.z; WT[(7 + 4 * q) * DM + k] = e4.w; }
    }
    f32x4 gn[4];
#pragma unroll
    for (int j = 0; j < 4; ++j) gn[j] = ((const f32x4*)P.norm2_g)[lane + 64 * j];
    for (int blk = blockIdx.x; blk < NX / 64; blk += gridDim.x) {
        if (tid < 16) lcnt[tid] = 0;
        __syncthreads();
        const int r0 = blk * 64;
        for (int rr = 0; rr < 8; ++rr) {
            const int rl = wave * 8 + rr, r = r0 + rl;
            const f32x4* hr = (const f32x4*)(H1 + (size_t)r * DM) + lane;
            f32x4 v[4]; float s = 0.f;
#pragma unroll
            for (int j = 0; j < 4; ++j) { v[j] = hr[64 * j]; s += (v[j].x * v[j].x + v[j].y * v[j].y) + (v[j].z * v[j].z + v[j].w * v[j].w); }
            const float rs = rsqrtf(wave_sum(s) * (1.f / DM) + EPS);
            u32x2* o = (u32x2*)(HN2 + (size_t)r * DM) + lane;
            float lg[20];
#pragma unroll
            for (int e = 0; e < 20; ++e) lg[e] = 0.f;
#pragma unroll
            for (int j = 0; j < 4; ++j) {
                const f32x4 hn = {v[j].x * rs * gn[j].x, v[j].y * rs * gn[j].y, v[j].z * rs * gn[j].z, v[j].w * rs * gn[j].w};
                o[64 * j] = (u32x2){pk2(hn.x, hn.y), pk2(hn.z, hn.w)};
#pragma unroll
                for (int e = 0; e < 20; ++e) { const f32x4 w4 = *(const LAS f32x4*)(WT + e * DM + (lane + 64 * j) * 4); lg[e] += (hn.x * w4.x + hn.y * w4.y) + (hn.z * w4.z + hn.w * w4.w); }
            }
#pragma unroll
            for (int e = 0; e < 20; ++e) lg[e] = wave_sum(lg[e]);
            if (lane == 0) {
                float gl[4]; int gs = 0;
#pragma unroll
                for (int g = 0; g < 4; ++g) gl[g] = lg[g] + P.b_rg[g];
#pragma unroll
                for (int g = 1; g < 4; ++g) if (gl[g] > gl[gs]) gs = g;
                float den = 0.f;
#pragma unroll
                for (int g = 0; g < 4; ++g) den += expf(gl[g] - gl[gs]);
                const float pg = 1.f / den;
                float el[4];
#pragma unroll
                for (int q = 0; q < 4; ++q) { float a = 0.f;
#pragma unroll
                    for (int g = 0; g < 4; ++g) a = (g == gs) ? lg[4 + g * 4 + q] : a;
                    el[q] = a + P.b_re[gs * 4 + q]; }
                int i1 = 0;
#pragma unroll
                for (int q = 1; q < 4; ++q) if (el[q] > el[i1]) i1 = q;
                int i2 = (i1 == 0) ? 1 : 0;
#pragma unroll
                for (int q = 0; q < 4; ++q) if (q != i1 && el[q] > el[i2]) i2 = q;
                const float ed = expf(el[i2] - el[i1]);
                const float w1 = pg / (1.f + ed), w2 = pg * ed / (1.f + ed);
                const int e1 = gs * 4 + i1, e2 = gs * 4 + i2;
                const int q1 = __hip_atomic_fetch_add(lcnt + e1, 1, __ATOMIC_RELAXED, __HIP_MEMORY_SCOPE_WORKGROUP), q2 = __hip_atomic_fetch_add(lcnt + e2, 1, __ATOMIC_RELAXED, __HIP_MEMORY_SCOPE_WORKGROUP);
                ent[rl * 2] = (e1 << 16) | q1; ent[rl * 2 + 1] = (e2 << 16) | q2;
                tokw[r * 2] = w1; tokw[r * 2 + 1] = w2;
            }
        }
        __syncthreads();
        if (tid < 16) lbase[tid] = (int)atomicAdd(cnt + tid, (unsigned)lcnt[tid]);
        __syncthreads();
        if (tid < 128) { const int en = ent[tid], e = en >> 16, q = en & 0xffff; list[(size_t)e * NX + lbase[e] + q] = (r0 + (tid >> 1)) * 2 + (tid & 1); }
        __syncthreads();
    }
}
__device__ __forceinline__ void ph_final(const Params& P) {
    const int tid = threadIdx.x, lane = tid & 63, wave = tid >> 6, nw = blockDim.x >> 6;
    const int gw = blockIdx.x * nw + wave, NGW = gridDim.x * nw;
    const h16* YE = (const h16*)(P.ws + WS_RG); const float* H1 = (const float*)(P.ws + WS_RC);
    f32x4 gf[4];
#pragma unroll
    for (int j = 0; j < 4; ++j) gf[j] = ((const f32x4*)P.final_g)[lane + 64 * j];
    for (int r = gw; r < NX; r += NGW) {
        const f32x4* hr = (const f32x4*)(H1 + (size_t)r * DM) + lane; f32x4* orow = (f32x4*)(P.out + (size_t)r * DM) + lane;
        const h16x4* y0 = (const h16x4*)(YE + (size_t)(2 * r) * DM) + lane; const h16x4* y1 = (const h16x4*)(YE + (size_t)(2 * r + 1) * DM) + lane;
        f32x4 v[4]; h16x4 a[4], bq[4]; float s = 0.f;
#pragma unroll
        for (int j = 0; j < 4; ++j) { v[j] = hr[64 * j]; a[j] = y0[64 * j]; bq[j] = y1[64 * j]; }
#pragma unroll
        for (int j = 0; j < 4; ++j) {
            v[j].x += (float)a[j][0] + (float)bq[j][0]; v[j].y += (float)a[j][1] + (float)bq[j][1]; v[j].z += (float)a[j][2] + (float)bq[j][2]; v[j].w += (float)a[j][3] + (float)bq[j][3];
            s += (v[j].x * v[j].x + v[j].y * v[j].y) + (v[j].z * v[j].z + v[j].w * v[j].w); }
        const float rs = rsqrtf(wave_sum(s) * (1.f / DM) + EPS);
#pragma unroll
        for (int j = 0; j < 4; ++j) orow[64 * j] = (f32x4){v[j].x * rs * gf[j].x, v[j].y * rs * gf[j].y, v[j].z * rs * gf[j].z, v[j].w * rs * gf[j].w};
    }
}

namespace pg8 {
#define PG8_LAS __attribute__((address_space(3)))
constexpr int BM = 256, BK = 64, HALF = 128, HTB = HALF * BK * 2, STAGE_BYTES = 8 * HTB, NXCD = 8, WGM = 8;
__host__ __device__ __forceinline__ int lds_byte(int r, int c) { const int st = (r >> 4) * 2 + (c >> 5), rr = r & 15, cc = c & 31, ob = rr * 64 + cc * 2; return st * 1024 + (ob ^ (((ob >> 9) & 1) << 5)); }
__host__ __device__ __forceinline__ void stage_rc(int b, int& R, int& C) { const int st = b / 1024, sb = b % 1024, swz = sb ^ (((sb >> 9) & 1) << 5); R = (st >> 1) * 16 + swz / 64; C = (st & 1) * 32 + (swz % 64) / 2; }
__host__ __device__ __forceinline__ int perm32(int rho) { const int n = rho >> 4, i = rho & 15; return 8 * (i >> 2) + 4 * n + (i & 3); }
struct Unit { const char* A; const char* B; unsigned lda, ldb; int nt, keep; int pm, pn, x0, x1, gat; const int* rows; };
__device__ __forceinline__ void tile_of(int L, int nM, int nN, int& pm, int& pn) {
    const int nwg = nM * nN; int wgid = L; { const int q = nwg / NXCD, r = nwg % NXCD, xcd = wgid % NXCD, off = wgid / NXCD; wgid = (xcd < r ? xcd * (q + 1) : r * (q + 1) + (xcd - r) * q) + off; }
    const int nig = WGM * nN, gid = wgid / nig, fm = gid * WGM, gsz = (nM - fm) < WGM ? (nM - fm) : WGM;
    pm = fm + ((wgid % nig) % gsz); pn = (wgid % nig) / gsz;
}
template <bool PERM>
__device__ __forceinline__ void unit_voff(const Unit& u, int tid, unsigned (&vA)[2][2], unsigned (&vB)[2][2]) {
#pragma unroll
    for (int i = 0; i < 2; ++i) { int R, C; stage_rc(tid * 16 + i * 8192, R, C); const int Rb = PERM ? ((R & ~31) + perm32(R & 31)) : R;
#pragma unroll
        for (int h = 0; h < 2; ++h) { int ra = R + HALF * h;
            if (u.gat) { const int idx = ra < u.x0 ? ra : u.x0 - 1; ra = u.rows[idx] >> 1; }
            vA[h][i] = (unsigned)ra * u.lda + (unsigned)C * 2u; vB[h][i] = (unsigned)(Rb + HALF * h) * u.ldb + (unsigned)C * 2u; } }
}
template <bool PERM, class Sched, class Epi>
__device__ __forceinline__ void gemm_phase(PG8_LAS unsigned char* lds, const Sched& S, const Epi& E) {
    const int tid = threadIdx.x, wid = __builtin_amdgcn_readfirstlane(tid >> 6), lane = tid & 63, wr = wid >> 2, wc = wid & 3, fr = lane & 15, fq = lane >> 4;
    const size_t kstep = (size_t)(BK * 2);
    const unsigned ldsw = (unsigned)wid * 1024u;
    const int aoff = lds_byte(wr * 64 + fr, fq * 8), boff = lds_byte(wc * 32 + fr, fq * 8);
#define PG8_SA(b, h) (((b) * 2 + (h)) * HTB)
#define PG8_SB(b, h) ((4 + (b) * 2 + (h)) * HTB)
#define PG8_STAGE(bufoff, gbase, voff) do { _Pragma("unroll") for (int _i = 0; _i < 2; ++_i) \
        __builtin_amdgcn_global_load_lds((const unsigned*)((const char*)(gbase) + (voff)[_i]), (PG8_LAS unsigned*)(lds + (bufoff) + ldsw + _i * 8192), 16, 0, 0); } while (0)
#define PG8_LDA(dst, b, h) do { _Pragma("unroll") for (int m = 0; m < 4; ++m) _Pragma("unroll") for (int k = 0; k < 2; ++k) dst[m][k] = *(const PG8_LAS h16x8*)(lds + PG8_SA(b, h) + aoff + m * 2048 + k * 1024); } while (0)
#define PG8_LDB(dst, b, h) do { _Pragma("unroll") for (int n = 0; n < 2; ++n) _Pragma("unroll") for (int k = 0; k < 2; ++k) dst[n][k] = *(const PG8_LAS h16x8*)(lds + PG8_SB(b, h) + boff + n * 2048 + k * 1024); } while (0)
#define PG8_MMA(ai, bj, At, Bt) do { __builtin_amdgcn_s_setprio(1); _Pragma("unroll") for (int m = 0; m < 4; ++m) _Pragma("unroll") for (int n = 0; n < 2; ++n) _Pragma("unroll") for (int k = 0; k < 2; ++k) \
        acc[ai][bj][m][n] = __builtin_amdgcn_mfma_f32_16x16x32_f16(Bt[n][k], At[m][k], acc[ai][bj][m][n], 0, 0, 0); __builtin_amdgcn_s_setprio(0); } while (0)
#define PG8_WAIT_V(n) asm volatile("s_waitcnt vmcnt(" #n ")" ::: "memory")
#define PG8_WAIT_L(n) asm volatile("s_waitcnt lgkmcnt(" #n ")" ::: "memory")
#define PG8_BAR __builtin_amdgcn_s_barrier()
#define PG8_SCHED __builtin_amdgcn_sched_barrier(0)
    Unit cur, nxt; int ui = 0;
    if (!S.next(0, cur)) return;
    f32x4 acc[2][2][4][2];
#pragma unroll
    for (int a = 0; a < 2; ++a)
#pragma unroll
        for (int b = 0; b < 2; ++b)
#pragma unroll
            for (int m = 0; m < 4; ++m)
#pragma unroll
                for (int n = 0; n < 2; ++n) acc[a][b][m][n] = (f32x4){0.f, 0.f, 0.f, 0.f};
    h16x8 At[4][2], B0[2][2], B1[2][2];
    unsigned vA[2][2], vB[2][2], nvA[2][2], nvB[2][2];
    unit_voff<PERM>(cur, tid, vA, vB);
    const char* cA = cur.A; const char* cB = cur.B;
    PG8_STAGE(PG8_SB(0, 0), cB, vB[0]); PG8_STAGE(PG8_SB(0, 1), cB, vB[1]); PG8_STAGE(PG8_SA(0, 0), cA, vA[0]); PG8_STAGE(PG8_SA(0, 1), cA, vA[1]);
    if (wr == 1) PG8_BAR;
    PG8_WAIT_V(2); PG8_BAR;
    PG8_STAGE(PG8_SB(1, 0), cB + kstep, vB[0]); PG8_STAGE(PG8_SA(1, 0), cA + kstep, vA[0]); PG8_STAGE(PG8_SB(1, 1), cB + kstep, vB[1]);
    PG8_WAIT_V(6); PG8_BAR;
    for (;;) {
        const bool has_next = S.next(ui + 1, nxt);
        const char* nA = has_next ? nxt.A : cA; const char* nB = has_next ? nxt.B : cB;
        if (has_next) unit_voff<PERM>(nxt, tid, nvA, nvB);
        else {
#pragma unroll
            for (int h = 0; h < 2; ++h)
#pragma unroll
                for (int i = 0; i < 2; ++i) { nvA[h][i] = vA[h][i]; nvB[h][i] = vB[h][i]; } }
        const int nt = cur.nt;
        for (int t = 0; t < nt; t += 2) {
            const bool last = (t == nt - 2);
            const char* a1 = cA + (size_t)(t + 1) * kstep;
            const char* a2 = last ? nA : cA + (size_t)(t + 2) * kstep; const char* b2 = last ? nB : cB + (size_t)(t + 2) * kstep;
            const char* a3 = a2 + kstep; const char* b3 = b2 + kstep;
            unsigned wA[2][2], wB[2][2];
#pragma unroll
            for (int h = 0; h < 2; ++h)
#pragma unroll
                for (int i = 0; i < 2; ++i) { wA[h][i] = last ? nvA[h][i] : vA[h][i]; wB[h][i] = last ? nvB[h][i] : vB[h][i]; }
            PG8_LDB(B0, 0, 0); PG8_LDB(B1, 0, 1); PG8_SCHED; PG8_LDA(At, 0, 0); PG8_STAGE(PG8_SA(1, 1), a1, vA[1]);
            PG8_WAIT_V(8); PG8_WAIT_L(0); PG8_BAR; PG8_MMA(0, 0, At, B0); PG8_MMA(0, 1, At, B1); PG8_BAR; PG8_SCHED;
            PG8_LDA(At, 0, 1); PG8_STAGE(PG8_SB(0, 0), b2, wB[0]); PG8_STAGE(PG8_SB(0, 1), b2, wB[1]); PG8_STAGE(PG8_SA(0, 0), a2, wA[0]);
            PG8_WAIT_V(8); PG8_WAIT_L(0); PG8_BAR; PG8_MMA(1, 0, At, B0); PG8_MMA(1, 1, At, B1); PG8_BAR; PG8_SCHED;
            PG8_LDB(B0, 1, 0); PG8_LDB(B1, 1, 1); PG8_SCHED; PG8_LDA(At, 1, 0); PG8_STAGE(PG8_SA(0, 1), a2, wA[1]);
            PG8_WAIT_V(8); PG8_WAIT_L(0); PG8_BAR; PG8_MMA(0, 0, At, B0); PG8_MMA(0, 1, At, B1); PG8_BAR; PG8_SCHED;
            PG8_LDA(At, 1, 1); PG8_STAGE(PG8_SB(1, 0), b3, wB[0]); PG8_STAGE(PG8_SB(1, 1), b3, wB[1]); PG8_STAGE(PG8_SA(1, 0), a3, wA[0]);
            PG8_WAIT_V(8); PG8_WAIT_L(0); PG8_BAR; PG8_MMA(1, 0, At, B0); PG8_MMA(1, 1, At, B1); PG8_BAR; PG8_SCHED;
        }
        if (wr == 0) PG8_BAR;
        E(acc, cur, wr, wc, fr, fq);
        if (!has_next) break;
        if (!nxt.keep) {
#pragma unroll
            for (int a = 0; a < 2; ++a)
#pragma unroll
                for (int b = 0; b < 2; ++b)
#pragma unroll
                    for (int m = 0; m < 4; ++m)
#pragma unroll
                        for (int n = 0; n < 2; ++n) acc[a][b][m][n] = (f32x4){0.f, 0.f, 0.f, 0.f};
        }
        cur = nxt; cA = nA; cB = nB; ++ui;
#pragma unroll
        for (int h = 0; h < 2; ++h)
#pragma unroll
            for (int i = 0; i < 2; ++i) { vA[h][i] = nvA[h][i]; vB[h][i] = nvB[h][i]; }
        if (wr == 1) PG8_BAR;
    }
    PG8_WAIT_V(0);
    PG8_BAR;
#undef PG8_SA
#undef PG8_SB
#undef PG8_STAGE
#undef PG8_LDA
#undef PG8_LDB
#undef PG8_MMA
#undef PG8_WAIT_V
#undef PG8_WAIT_L
#undef PG8_BAR
#undef PG8_SCHED
}
struct SchedGrid {
    const char* A; const char* B; unsigned lda, ldb; int nt, nM, nN, G, c;
    __device__ __forceinline__ bool next(int i, Unit& u) const {
        const int L = i * G + c; if (L >= nM * nN) return false;
        int pm, pn; tile_of(L, nM, nN, pm, pn);
        u.A = A + (size_t)pm * BM * lda; u.B = B + (size_t)pn * BM * ldb; u.lda = lda; u.ldb = ldb; u.nt = nt; u.keep = 0; u.pm = pm; u.pn = pn; u.x0 = 0; u.x1 = 0; u.gat = 0; u.rows = nullptr; return true;
    }
};
struct SchedMixed {
    const char *Y, *WE, *AT, *WA; int G, c;
    __device__ __forceinline__ bool next(int i, Unit& u) const {
        const int L = (i >> 1) * G + c; if (L >= (NX / BM) * (DM / BM)) return false;
        int pm, pn; tile_of(L, NX / BM, DM / BM, pm, pn);
        u.pm = pm; u.pn = pn; u.x0 = 0; u.gat = 0; u.rows = nullptr;
        if ((i & 1) == 0) { u.A = Y + (size_t)pm * BM * (PW * 2); u.B = WE + (size_t)pn * BM * (PW * 2); u.lda = PW * 2; u.ldb = PW * 2; u.nt = PW / BK; u.keep = 0; u.x1 = 0; }
        else { u.A = AT + (size_t)pm * BM * (DM * 2); u.B = WA + (size_t)pn * BM * (DM * 2); u.lda = DM * 2; u.ldb = DM * 2; u.nt = DM / BK; u.keep = 1; u.x1 = 1; }
        return true;
    }
};
struct SchedMoE {
    const unsigned* cnt; const int* list; const char* A; const char* B; unsigned lda, ldb; int nt, gather, G, vc; size_t bstride;
    __device__ __forceinline__ bool next(int i, Unit& u) const {
        const int L = i * G + vc; int rt = L >> 2; const int ct = L & 3; int off = 0;
        for (int e = 0; e < NE; ++e) {
            const int n = (int)cnt[e], tiles = (n + BM - 1) >> 8;
            if (rt < tiles) {
                u.rows = list + (size_t)e * NX + rt * BM; u.x0 = (n - rt * BM) < BM ? (n - rt * BM) : BM; u.x1 = 0; u.gat = gather;
                u.pm = off + rt * BM; u.pn = ct; u.lda = lda; u.ldb = ldb; u.nt = nt; u.keep = 0;
                u.A = gather ? A : A + (size_t)(off + rt * BM) * lda; u.B = B + (size_t)e * bstride + (size_t)ct * BM * ldb; return true;
            }
            rt -= tiles; off += n;
        }
        return false;
    }
};
struct EpiZ8 {
    const float* rope; const float* b_gate; h16 *Q, *K, *V, *U, *G0, *R;
    __device__ __forceinline__ void operator()(f32x4 (&acc)[2][2][4][2], const Unit& u, int wr, int wc, int fr, int fq) const {
        const int sec = u.pn;
#pragma unroll
        for (int bj = 0; bj < 2; ++bj) {
            const int colt = u.pn * BM + bj * HALF + wc * 32 + 8 * fq;
            f32x4 bg0 = {0.f, 0.f, 0.f, 0.f}, bg1 = {0.f, 0.f, 0.f, 0.f};
            if (sec >= 14) { const int j0 = (colt - O_G) >> 1; bg0 = *(const f32x4*)(b_gate + j0); bg1 = *(const f32x4*)(b_gate + DM + j0); }
#pragma unroll
            for (int ai = 0; ai < 2; ++ai)
#pragma unroll
                for (int m = 0; m < 4; ++m) {
                    const int row = u.pm * BM + ai * HALF + wr * 64 + m * 16 + fr;
                    const f32x4 v0 = acc[ai][bj][m][0], v1 = acc[ai][bj][m][1];
                    if (sec < 8) {
                        const int t = pos_of_row(row), i0 = (colt & 63) >> 1;
                        const f32x4 c0 = *(const f32x4*)(rope + ((size_t)t * 32 + i0) * 2), c1 = *(const f32x4*)(rope + ((size_t)t * 32 + i0 + 2) * 2);
                        float o0 = v0.x * c0.x - v0.y * c0.y, o1 = v0.y * c0.x + v0.x * c0.y, o2 = v0.z * c0.z - v0.w * c0.w, o3 = v0.w * c0.z + v0.z * c0.w;
                        float o4 = v1.x * c1.x - v1.y * c1.y, o5 = v1.y * c1.x + v1.x * c1.y, o6 = v1.z * c1.z - v1.w * c1.w, o7 = v1.w * c1.z + v1.z * c1.w;
                        if (sec < 4) { o0 *= C2; o1 *= C2; o2 *= C2; o3 *= C2; o4 *= C2; o5 *= C2; o6 *= C2; o7 *= C2; }
                        h16* dst = (sec < 4 ? Q : K) + (size_t)row * DM + (colt & (DM - 1));
                        *(u32x4*)dst = (u32x4){pk2(o0, o1), pk2(o2, o3), pk2(o4, o5), pk2(o6, o7)};
                    } else if (sec < 12) {
                        *(u32x4*)(V + (size_t)row * DM + (colt - O_V)) = (u32x4){pk2(v0.x, v0.y), pk2(v0.z, v0.w), pk2(v1.x, v1.y), pk2(v1.z, v1.w)};
                    } else if (sec < 14) {
                        *(u32x4*)(U + (size_t)row * PW + (colt - O_P)) = (u32x4){pk2(v0.x, v0.y), pk2(v0.z, v0.w), pk2(v1.x, v1.y), pk2(v1.z, v1.w)};
                    } else if (row < NX) {
                        const int j0 = (colt - O_G) >> 1;
                        const float e0 = __expf(-(v0.x + bg0.x)), f0 = __expf(-(v0.y + bg1.x)), e1 = __expf(-(v0.z + bg0.y)), f1 = __expf(-(v0.w + bg1.y));
                        const float e2 = __expf(-(v1.x + bg0.z)), f2 = __expf(-(v1.y + bg1.z)), e3 = __expf(-(v1.z + bg0.w)), f3 = __expf(-(v1.w + bg1.w));
                        *(u32x2*)(G0 + (size_t)row * DM + j0) = (u32x2){pk2(1.f / (1.f + e0), 1.f / (1.f + e1)), pk2(1.f / (1.f + e2), 1.f / (1.f + e3))};
                        *(u32x2*)(R + (size_t)row * DM + j0) = (u32x2){pk2((1.f + e0) / (1.f + f0), (1.f + e1) / (1.f + f1)), pk2((1.f + e2) / (1.f + f2), (1.f + e3) / (1.f + f3))};
                    }
                }
        }
    }
};
struct EpiMixed {
    const h16* G0; const h16* R; h16* MX;
    __device__ __forceinline__ void operator()(f32x4 (&acc)[2][2][4][2], const Unit& u, int wr, int wc, int fr, int fq) const {
#pragma unroll
        for (int ai = 0; ai < 2; ++ai)
#pragma unroll
            for (int m = 0; m < 4; ++m)
#pragma unroll
                for (int bj = 0; bj < 2; ++bj) {
                    const size_t o = (size_t)(u.pm * BM + ai * HALF + wr * 64 + m * 16 + fr) * DM + u.pn * BM + bj * HALF + wc * 32 + 8 * fq;
                    if (u.x1 == 0) { const h16x8 r = *(const h16x8*)(R + o);
                        acc[ai][bj][m][0] *= (f32x4){(float)r[0], (float)r[1], (float)r[2], (float)r[3]}; acc[ai][bj][m][1] *= (f32x4){(float)r[4], (float)r[5], (float)r[6], (float)r[7]};
                    } else { const h16x8 g = *(const h16x8*)(G0 + o); const f32x4 v0 = acc[ai][bj][m][0], v1 = acc[ai][bj][m][1];
                        *(u32x4*)(MX + o) = (u32x4){pk2(v0.x * (float)g[0], v0.y * (float)g[1]), pk2(v0.z * (float)g[2], v0.w * (float)g[3]), pk2(v1.x * (float)g[4], v1.y * (float)g[5]), pk2(v1.z * (float)g[6], v1.w * (float)g[7])}; }
                }
    }
};
struct EpiH1 {
    const float* x; float* out;
    __device__ __forceinline__ void operator()(f32x4 (&acc)[2][2][4][2], const Unit& u, int wr, int wc, int fr, int fq) const {
#pragma unroll
        for (int ai = 0; ai < 2; ++ai)
#pragma unroll
            for (int m = 0; m < 4; ++m)
#pragma unroll
                for (int bj = 0; bj < 2; ++bj)
#pragma unroll
                    for (int n = 0; n < 2; ++n) {
                        const size_t o = (size_t)(u.pm * BM + ai * HALF + wr * 64 + m * 16 + fr) * DM + u.pn * BM + bj * HALF + wc * 32 + 16 * n + 4 * fq;
                        *(f32x4*)(out + o) = *(const f32x4*)(x + o) + acc[ai][bj][m][n]; }
    }
};
struct EpiAct {
    h16* ACT;
    __device__ __forceinline__ void operator()(f32x4 (&acc)[2][2][4][2], const Unit& u, int wr, int wc, int fr, int fq) const {
#pragma unroll
        for (int ai = 0; ai < 2; ++ai)
#pragma unroll
            for (int m = 0; m < 4; ++m) {
                const int rr = ai * HALF + wr * 64 + m * 16 + fr;
                if (rr < u.x0) {
#pragma unroll
                    for (int bj = 0; bj < 2; ++bj) { const f32x4 v0 = acc[ai][bj][m][0], v1 = acc[ai][bj][m][1];
                        const float a0 = v0.x / (1.f + __expf(-v0.x)) * v0.y, a1 = v0.z / (1.f + __expf(-v0.z)) * v0.w, a2 = v1.x / (1.f + __expf(-v1.x)) * v1.y, a3 = v1.z / (1.f + __expf(-v1.z)) * v1.w;
                        *(u32x2*)(ACT + (size_t)(u.pm + rr) * DE + ((u.pn * BM + bj * HALF + wc * 32 + 8 * fq) >> 1)) = (u32x2){pk2(a0, a1), pk2(a2, a3)}; }
                }
            }
    }
};
struct EpiYE {
    h16* YE; const float* tokw;
    __device__ __forceinline__ void operator()(f32x4 (&acc)[2][2][4][2], const Unit& u, int wr, int wc, int fr, int fq) const {
#pragma unroll
        for (int ai = 0; ai < 2; ++ai)
#pragma unroll
            for (int m = 0; m < 4; ++m) {
                const int rr = ai * HALF + wr * 64 + m * 16 + fr;
                if (rr < u.x0) { const int ts = u.rows[rr]; const float w = tokw[ts];
#pragma unroll
                    for (int bj = 0; bj < 2; ++bj) { const f32x4 v0 = acc[ai][bj][m][0] * w, v1 = acc[ai][bj][m][1] * w;
                        *(u32x4*)(YE + (size_t)ts * DM + u.pn * BM + bj * HALF + wc * 32 + 8 * fq) = (u32x4){pk2(v0.x, v0.y), pk2(v0.z, v0.w), pk2(v1.x, v1.y), pk2(v1.z, v1.w)}; }
                }
            }
    }
};
}
__device__ __forceinline__ int xcd_vc(int G, int bx) { return (G % 8 == 0) ? (bx % 8) * (G / 8) + bx / 8 : bx; }
__device__ __forceinline__ void gp1_zgemm(const Params& P, PG8_LAS unsigned char* lds) {
    unsigned char* ws = P.ws;
    pg8::SchedGrid S{(const char*)(ws + WS_RA), (const char*)(ws + WS_WIN), DM * 2, DM * 2, DM / 64, MROWS / 256, IN_W / 256, (int)gridDim.x, (int)blockIdx.x};
    pg8::EpiZ8 E{(const float*)(ws + WS_ROPE), P.b_gate, (h16*)(ws + WS_RB), (h16*)(ws + WS_RC), (h16*)(ws + WS_RD), (h16*)(ws + WS_RE), (h16*)(ws + WS_RG), (h16*)(ws + WS_RG + 32 * MiB)};
    pg8::gemm_phase<true>(lds, S, E);
}
__device__ __forceinline__ void gp3a_mixed(const Params& P, PG8_LAS unsigned char* lds) {
    unsigned char* ws = P.ws;
    pg8::SchedMixed S{(const char*)(ws + WS_RF), (const char*)(ws + WS_WEFF), (const char*)(ws + WS_RB), (const char*)(ws + WS_WA), (int)gridDim.x, (int)blockIdx.x};
    pg8::EpiMixed E{(const h16*)(ws + WS_RG), (const h16*)(ws + WS_RG + 32 * MiB), (h16*)(ws + WS_RA)};
    pg8::gemm_phase<true>(lds, S, E);
}
__device__ __forceinline__ void gp3b_h1(const Params& P, PG8_LAS unsigned char* lds) {
    unsigned char* ws = P.ws;
    pg8::SchedGrid S{(const char*)(ws + WS_RA), (const char*)(ws + WS_WOUT), DM * 2, DM * 2, DM / 64, NX / 256, DM / 256, (int)gridDim.x, (int)blockIdx.x};
    pg8::EpiH1 E{P.x, (float*)(ws + WS_RC)};
    pg8::gemm_phase<false>(lds, S, E);
}
__device__ __forceinline__ void gp4_moe1(const Params& P, PG8_LAS unsigned char* lds) {
    unsigned char* ws = P.ws;
    pg8::SchedMoE S{(const unsigned*)(ws + WS_CTL) + CW_CNT, (const int*)(ws + WS_LIST), (const char*)(ws + WS_RB), (const char*)P.out, DM * 2, DM * 2, DM / 64, 1, (int)gridDim.x, xcd_vc((int)gridDim.x, (int)blockIdx.x), (size_t)(2 * DE) * DM * 2};
    pg8::EpiAct E{(h16*)(ws + WS_RA)};
    pg8::gemm_phase<true>(lds, S, E);
}
__device__ __forceinline__ void gp5_moe2(const Params& P, PG8_LAS unsigned char* lds) {
    unsigned char* ws = P.ws;
    pg8::SchedMoE S{(const unsigned*)(ws + WS_CTL) + CW_CNT, (const int*)(ws + WS_LIST), (const char*)(ws + WS_RA), (const char*)P.out + 32 * MiB, DE * 2, DE * 2, DE / 64, 0, (int)gridDim.x, xcd_vc((int)gridDim.x, (int)blockIdx.x), (size_t)DM * DE * 2};
    pg8::EpiYE E{(h16*)(ws + WS_RG), (const float*)(ws + WS_TOKW)};
    pg8::gemm_phase<true>(lds, S, E);
}

namespace att {
typedef float f32x16 __attribute__((ext_vector_type(16)));
typedef short s16x4 __attribute__((ext_vector_type(4)));
typedef __attribute__((address_space(3))) unsigned char* lptr;
constexpr int SLOT_K = 8192, SLOT_V = 16384, NSLOT = 3;
constexpr int L_K = 0, L_V = NSLOT * SLOT_K, L_WS = L_V + NSLOT * SLOT_V, L_OST = L_WS + 8 * 256, L_END = L_OST + 8 * 8192;
constexpr float THR = 8.f;
__device__ __forceinline__ int crow(int r, int hi) { return (r & 3) + 8 * (r >> 2) + 4 * hi; }
__device__ __forceinline__ void glds16(const void* gsrc, unsigned lds_dst) { unsigned keep;
    asm volatile("s_mov_b32 %0, m0\n\ts_mov_b32 m0, %2\n\ts_nop 0\n\tglobal_load_lds_dwordx4 %1, off\n\ts_mov_b32 m0, %0" : "=&s"(keep) : "v"(gsrc), "s"(lds_dst) : "memory"); }
#define ATT_WAIT_BAR(N) asm volatile("s_waitcnt vmcnt(" #N ") lgkmcnt(0)\n\ts_barrier" ::: "memory")
__device__ __forceinline__ h16x4 vtr(lptr p) { return __builtin_bit_cast(h16x4, __builtin_amdgcn_ds_read_tr16_b64_v4i16((__attribute__((address_space(3))) s16x4*)p)); }
__device__ __forceinline__ void attn_unit(int b, int h, int qb, const h16* Qb, const h16* Kb, const h16* Vb, h16* Ab, const float* subln_g, float lam, lptr shm) {
    const int tid = threadIdx.x, lane = tid & 63, r32 = lane & 31, hi = lane >> 5; const int wid = __builtin_amdgcn_readfirstlane(tid >> 6);
    const unsigned lds0 = (unsigned)(uintptr_t)shm;
    __attribute__((address_space(3))) float* wsf = (__attribute__((address_space(3))) float*)(shm + L_WS) + wid * 64;
    __attribute__((address_space(3))) h16* stg = (__attribute__((address_space(3))) h16*)(shm + L_OST) + wid * 4096;
    const int NT = 4 * (qb + 1) + 1;
    const int qi = 256 * qb + 32 * wid + r32;
    const size_t qrow = (size_t)b * SEQ + qi;
    const h16* Vh = Vb + h * 128;
    const int vrow = 16 * (wid & 3) + (lane >> 2), vcol = (wid >> 2) * 32 + (lane & 3) * 8;
    for (int c = 0; c < 2; ++c) {
        const h16* Kc = Kb + h * 128 + c * 64;
#define ATT_DMA(j, slot) do { const int rb_ = (j) == 0 ? NX : b * SEQ + 64 * ((j) - 1); \
        glds16(Kc + (size_t)(rb_ + lane) * DM + wid * 8, (unsigned)__builtin_amdgcn_readfirstlane(lds0 + L_K + (slot) * SLOT_K + wid * 1024)); \
        glds16(Vh + (size_t)(rb_ + vrow) * DM + vcol, (unsigned)__builtin_amdgcn_readfirstlane(lds0 + L_V + (slot) * SLOT_V + wid * 1024)); \
        glds16(Vh + (size_t)(rb_ + vrow) * DM + 64 + vcol, (unsigned)__builtin_amdgcn_readfirstlane(lds0 + L_V + (slot) * SLOT_V + (wid + 8) * 1024)); } while (0)
        h16x8 qr[4];
#pragma unroll
        for (int d0 = 0; d0 < 4; ++d0) qr[d0] = *(const h16x8*)(Qb + qrow * DM + h * 128 + c * 64 + d0 * 16 + hi * 8);
        asm volatile("" : "+v"(qr[0]), "+v"(qr[1]), "+v"(qr[2]), "+v"(qr[3]));
        ATT_DMA(0, 0); ATT_DMA(1, 1);
        f32x16 o[4];
#pragma unroll
        for (int d = 0; d < 4; ++d)
#pragma unroll
            for (int r = 0; r < 16; ++r) o[d][r] = 0.f;
        float m = 0.f, l = 0.f; int slot = 0;
        for (int t = 0; t < NT; ++t) {
            if (t + 1 < NT) ATT_WAIT_BAR(3); else ATT_WAIT_BAR(0);
            if (t + 2 < NT) { const int s2 = slot == 0 ? 2 : slot - 1; ATT_DMA(t + 2, s2); }
            const lptr kp = shm + L_K + slot * SLOT_K + hi * 1024 + r32 * 16;
            f32x16 p0, p1;
#pragma unroll
            for (int r = 0; r < 16; ++r) { p0[r] = 0.f; p1[r] = 0.f; }
#pragma unroll
            for (int d0 = 0; d0 < 4; ++d0) {
                const h16x8 k0 = *(const __attribute__((address_space(3))) h16x8*)(kp + d0 * 2048), k1 = *(const __attribute__((address_space(3))) h16x8*)(kp + d0 * 2048 + 512);
                p0 = __builtin_amdgcn_mfma_f32_32x32x16_f16(k0, qr[d0], p0, 0, 0, 0); p1 = __builtin_amdgcn_mfma_f32_32x32x16_f16(k1, qr[d0], p1, 0, 0, 0);
            }
            if (t == 0) {
#pragma unroll
                for (int r = 0; r < 16; ++r) { if (r >= 8) p0[r] = -INFINITY; p1[r] = -INFINITY; }
            } else if (t >= NT - 4) {
                const int kb = 64 * (t - 1) + 4 * hi;
#pragma unroll
                for (int r = 0; r < 16; ++r) { const int kv = kb + (r & 3) + 8 * (r >> 2); if (kv > qi) p0[r] = -INFINITY; if (kv + 32 > qi) p1[r] = -INFINITY; }
            }
            float rm = fmaxf(p0[0], p1[0]);
#pragma unroll
            for (int r = 1; r < 16; ++r) rm = fmaxf(rm, fmaxf(p0[r], p1[r]));
            rm = fmaxf(rm, __shfl_xor(rm, 32));
            if (t == 0) m = rm;
            else {
                const float d = rm - m;
                if (__any(d > THR)) {
                    const float dl = fmaxf(d, 0.f); m += dl; const float f = __builtin_amdgcn_exp2f(-dl); l *= f;
                    if (hi == 0) wsf[r32] = f;
                    __builtin_amdgcn_s_waitcnt(0xC07F); __builtin_amdgcn_wave_barrier();
#pragma unroll
                    for (int r = 0; r < 16; ++r) { const float fr_ = wsf[crow(r, hi)];
#pragma unroll
                        for (int dd = 0; dd < 4; ++dd) o[dd][r] *= fr_; }
                    __builtin_amdgcn_wave_barrier();
                }
            }
            float sacc = 0.f;
#pragma unroll
            for (int r = 0; r < 16; ++r) { p0[r] = __builtin_amdgcn_exp2f(p0[r] - m); p1[r] = __builtin_amdgcn_exp2f(p1[r] - m); sacc += p0[r] + p1[r]; }
            l += sacc;
            u32x4 pw[4];
            pw[0] = (u32x4){pk2(p0[0], p0[1]), pk2(p0[2], p0[3]), pk2(p0[4], p0[5]), pk2(p0[6], p0[7])};
            pw[1] = (u32x4){pk2(p0[8], p0[9]), pk2(p0[10], p0[11]), pk2(p0[12], p0[13]), pk2(p0[14], p0[15])};
            pw[2] = (u32x4){pk2(p1[0], p1[1]), pk2(p1[2], p1[3]), pk2(p1[4], p1[5]), pk2(p1[6], p1[7])};
            pw[3] = (u32x4){pk2(p1[8], p1[9]), pk2(p1[10], p1[11]), pk2(p1[12], p1[13]), pk2(p1[14], p1[15])};
            const lptr vp = shm + L_V + slot * SLOT_V + ((lane >> 4) & 1) * 32 + (lane & 3) * 8 + (4 * hi + ((lane & 15) >> 2)) * 64;
#pragma unroll
            for (int db = 0; db < 4; ++db)
#pragma unroll
                for (int ks = 0; ks < 4; ++ks) {
                    const h16x4 lo = vtr(vp + db * 4096 + ks * 1024), hh = vtr(vp + db * 4096 + ks * 1024 + 512);
                    const h16x8 vf = {lo[0], lo[1], lo[2], lo[3], hh[0], hh[1], hh[2], hh[3]};
                    o[db] = __builtin_amdgcn_mfma_f32_32x32x16_f16(__builtin_bit_cast(h16x8, pw[ks]), vf, o[db], 0, 0, 0);
                }
            slot = slot == 2 ? 0 : slot + 1;
        }
        l += __shfl_xor(l, 32);
        if (hi == 0) wsf[32 + r32] = l;
        __builtin_amdgcn_s_waitcnt(0xC07F); __builtin_amdgcn_wave_barrier();
        float rli[16];
#pragma unroll
        for (int r = 0; r < 16; ++r) rli[r] = 1.0f / wsf[32 + crow(r, hi)];
        if (c == 0) {
#pragma unroll
            for (int db = 0; db < 4; ++db)
#pragma unroll
                for (int r = 0; r < 16; ++r) stg[crow(r, hi) * 128 + db * 32 + r32] = (h16)(o[db][r] * rli[r]);
        } else {
#pragma unroll
            for (int db = 0; db < 4; ++db)
#pragma unroll
                for (int r = 0; r < 16; ++r) { const int ix = crow(r, hi) * 128 + db * 32 + r32; stg[ix] = (h16)((float)stg[ix] - lam * o[db][r] * rli[r]); }
            __builtin_amdgcn_s_waitcnt(0xC07F); __builtin_amdgcn_wave_barrier();
            const int ch = lane & 7;
            const f32x4 g0 = *(const f32x4*)(subln_g + ch * 8), g1 = *(const f32x4*)(subln_g + ch * 8 + 4), g2 = *(const f32x4*)(subln_g + 64 + ch * 8), g3 = *(const f32x4*)(subln_g + 64 + ch * 8 + 4);
#pragma unroll
            for (int i = 0; i < 4; ++i) {
                const int row = i * 8 + (lane >> 3);
                const h16x8 a = *(const __attribute__((address_space(3))) h16x8*)(stg + row * 128 + ch * 8), bb = *(const __attribute__((address_space(3))) h16x8*)(stg + row * 128 + 64 + ch * 8);
                float av[8], bv[8]; float ss = 0.f;
#pragma unroll
                for (int j = 0; j < 8; ++j) { av[j] = (float)a[j]; bv[j] = (float)bb[j]; ss += av[j] * av[j] + bv[j] * bv[j]; }
                ss += __shfl_xor(ss, 1); ss += __shfl_xor(ss, 2); ss += __shfl_xor(ss, 4);
                const float rs = rsqrtf(ss * (1.f / VD) + EPS) * (1.f - LAMBDA_INIT);
                h16* dst = Ab + ((size_t)b * SEQ + 256 * qb + 32 * wid + row) * DM + h * 128 + ch * 8;
                *(u32x4*)dst = (u32x4){pk2(av[0] * rs * g0.x, av[1] * rs * g0.y), pk2(av[2] * rs * g0.z, av[3] * rs * g0.w), pk2(av[4] * rs * g1.x, av[5] * rs * g1.y), pk2(av[6] * rs * g1.z, av[7] * rs * g1.w)};
                *(u32x4*)(dst + 64) = (u32x4){pk2(bv[0] * rs * g2.x, bv[1] * rs * g2.y), pk2(bv[2] * rs * g2.z, bv[3] * rs * g2.w), pk2(bv[4] * rs * g3.x, bv[5] * rs * g3.y), pk2(bv[6] * rs * g3.z, bv[7] * rs * g3.w)};
            }
        }
        asm volatile("s_waitcnt vmcnt(0) lgkmcnt(0)\n\ts_barrier" ::: "memory");
#undef ATT_DMA
    }
}
}
__device__ __forceinline__ void gp2_attn(const Params& P, att::lptr lds) {
    unsigned char* ws = P.ws;
    const h16* Q = (const h16*)(ws + WS_RB); const h16* Kb = (const h16*)(ws + WS_RC); const h16* Vb = (const h16*)(ws + WS_RD); h16* A = (h16*)(ws + WS_RB);
    const float lam = *(const float*)(ws + WS_LAM);
    const int G = (int)gridDim.x, vcu = (G % 8 == 0) ? ((int)blockIdx.x % 8) * (G / 8) + (int)blockIdx.x / 8 : (int)blockIdx.x;
    for (int u = vcu; u < NB * NH * 4; u += G) {
        const int bh = u >> 2, s = u & 3;
        att::attn_unit(bh >> 3, bh & 7, s, Q, Kb, Vb, A, P.subln_g, lam, lds);
        att::attn_unit(bh >> 3, bh & 7, 7 - s, Q, Kb, Vb, A, P.subln_g, lam, lds);
    }
    ph_pool(P);
}

#define XB_TMO      128
#define XB_XCNT(j)  (256  + 64 * (j))
#define XB_XSUB(j)  (1280 + 64 * (j))
#define XB_XGEN(j)  (2304 + 64 * (j))
#define XB_TOP      3328
#define XB_TOPGEN   3392
#define XCD_BAR_WORDS 3456
#define XB_SPIN_CAP (1u << 18)
constexpr int CW_BAR = 4096;
static_assert((CW_BAR + XCD_BAR_WORDS) * 4 <= (int)CTL_BYTES, "barrier words inside the memset region");
__device__ __forceinline__ unsigned xb_ld(unsigned* p)              { return __hip_atomic_load(p, __ATOMIC_RELAXED, __HIP_MEMORY_SCOPE_AGENT); }
__device__ __forceinline__ unsigned xb_add(unsigned* p, unsigned v) { return __hip_atomic_fetch_add(p, v, __ATOMIC_RELAXED, __HIP_MEMORY_SCOPE_AGENT); }
__device__ __forceinline__ unsigned xb_xcc_id() { return (unsigned)__builtin_amdgcn_s_getreg((3 << 11) | 20) & 0xFu; }
#define XB_SPIN(cond, bar) do { unsigned _sp = 0; while (cond) { __builtin_amdgcn_s_sleep(1); \
    if ((++_sp & 255u) == 0u) { if (xb_ld(&(bar)[XB_TMO])) break; if (_sp > XB_SPIN_CAP) { atomicAdd(&(bar)[XB_TMO], 1u); break; } } } } while (0)
struct XcdBarrier { unsigned* bar; unsigned x; volatile LAS unsigned* st; };
__device__ __forceinline__ XcdBarrier xcd_barrier_post(unsigned* bar, volatile LAS unsigned* st) {
    XcdBarrier b; b.bar = bar; b.x = xb_xcc_id(); b.st = st;
    if (threadIdx.x == 0) (void)xb_add(&bar[XB_XCNT(b.x)], 1u);
    return b;
}
__device__ __forceinline__ void xcd_barrier_complete(unsigned* bar, unsigned x, unsigned& nloc, unsigned& nx) {
    const unsigned G = gridDim.x * gridDim.y * gridDim.z;
    unsigned sum, cnt, mine, sp = 0u;
    for (;;) {
        sum = 0u; cnt = 0u; mine = 0u;
#pragma unroll
        for (unsigned j = 0; j < 16; ++j) { const unsigned c = xb_ld(&bar[XB_XCNT(j)]); sum += c; cnt += (c > 0u) ? 1u : 0u; mine = (j == x) ? c : mine; }
        if (sum == G) break;
        __builtin_amdgcn_s_sleep(1);
        if ((++sp & 255u) == 0u) { if (xb_ld(&bar[XB_TMO])) break; if (sp > XB_SPIN_CAP) { atomicAdd(&bar[XB_TMO], 1u); break; } }
    }
    nloc = mine > 0u ? mine : 1u; nx = cnt > 0u ? cnt : 1u;
}
__device__ __forceinline__ void xcd_barrier(const XcdBarrier& b) {
    asm volatile("s_waitcnt vmcnt(0)" ::: "memory");
    __syncthreads();
    if (threadIdx.x == 0) {
        unsigned* bar = b.bar;
        __builtin_amdgcn_s_waitcnt(0);
        unsigned nloc = b.st[0], nx = b.st[1];
        if (nloc == 0u) { xcd_barrier_complete(bar, b.x, nloc, nx); b.st[0] = nloc; b.st[1] = nx; }
        const unsigned old = xb_add(&bar[XB_XSUB(b.x)], 1u);
        const unsigned gen = old / nloc;
        if (old + 1u == (gen + 1u) * nloc) {
            __builtin_amdgcn_fence(__ATOMIC_RELEASE, "agent");
            asm volatile("s_waitcnt vmcnt(0)" ::: "memory");
            const unsigned og = xb_add(&bar[XB_TOP], 1u);
            const unsigned tg = og / nx;
            if (og + 1u == (tg + 1u) * nx) xb_add(&bar[XB_TOPGEN], 1u);
            else XB_SPIN(xb_ld(&bar[XB_TOPGEN]) == tg, bar);
            __builtin_amdgcn_fence(__ATOMIC_ACQUIRE, "agent");
            xb_add(&bar[XB_XGEN(b.x)], 1u);
            asm volatile("s_waitcnt vmcnt(0)" ::: "memory");
        } else {
            XB_SPIN(xb_ld(&bar[XB_XGEN(b.x)]) == gen, bar);
            __builtin_amdgcn_fence(__ATOMIC_ACQUIRE, "agent");
            asm volatile("s_waitcnt vmcnt(0)" ::: "memory");
        }
    }
    __syncthreads();
}

constexpr int NWAVES = 8, LDS_BYTES = 155648, MISC_OFF = 153600;
constexpr int N_PHASES = 9;
struct Args { Params P; int ph_lo, ph_hi, use_cg, pad; };
__global__ void __launch_bounds__(NWAVES * 64, 2) mk_fwd(Args a) {
    extern __shared__ __attribute__((aligned(16))) unsigned char lds_raw[];
    volatile LAS unsigned* MISC = (volatile LAS unsigned*)((LAS unsigned char*)lds_raw + MISC_OFF);
    if (threadIdx.x < 32) MISC[threadIdx.x] = 0u;
    __syncthreads();
    const bool one = (a.ph_hi - a.ph_lo) > 1;
    XcdBarrier bar; bar.bar = (unsigned*)(a.P.ws + WS_CTL) + CW_BAR; bar.x = 0; bar.st = nullptr;
    if (one) bar = xcd_barrier_post((unsigned*)(a.P.ws + WS_CTL) + CW_BAR, MISC + 8);
    if (a.use_cg) cooperative_groups::this_grid().sync();
    const Params& P = a.P;
    PG8_LAS unsigned char* L3 = (PG8_LAS unsigned char*)lds_raw;
#define PHASE(k, body) if (a.ph_lo <= (k) && (k) < a.ph_hi) { body; if ((k) + 1 < a.ph_hi) xcd_barrier(bar); }
    PHASE(0, ph0_prologue(P, L3))
    PHASE(1, gp1_zgemm(P, L3))
    PHASE(2, gp2_attn(P, (att::lptr)lds_raw))
    PHASE(3, gp3a_mixed(P, L3))
    PHASE(4, gp3b_h1(P, L3))
    PHASE(5, ph_route(P, L3))
    PHASE(6, gp4_moe1(P, L3))
    PHASE(7, gp5_moe2(P, L3))
    PHASE(8, ph_final(P))
#undef PHASE
}

#ifndef MK_N_LAUNCHES
#define MK_N_LAUNCHES 1
#endif
extern "C" void kernel_launch(void* const* d_in, const int* in_sizes, int n_in, void* d_out, int out_size, void* d_ws, size_t ws_size, hipStream_t stream) {
    static int grid = 0;
    if (grid == 0) {
        if (n_in != 24 || in_sizes[0] != NX * DM || out_size != NX * DM || ws_size < WS_END) {
            fprintf(stderr, "kernel_launch: unexpected shapes (n_in %d, in0 %d, out %d, ws %zu); nothing launched\n", n_in, n_in > 0 ? in_sizes[0] : -1, out_size, ws_size); grid = -1; return; }
        int dev = 0, cus = 0, per_cu = 0;
        if (hipGetDevice(&dev) != hipSuccess || hipDeviceGetAttribute(&cus, hipDeviceAttributeMultiprocessorCount, dev) != hipSuccess) { grid = -1; return; }
        if (hipFuncSetAttribute((const void*)mk_fwd, hipFuncAttributeMaxDynamicSharedMemorySize, LDS_BYTES) != hipSuccess) { fprintf(stderr, "kernel_launch: hipFuncSetAttribute failed\n"); grid = -1; return; }
        if (hipOccupancyMaxActiveBlocksPerMultiprocessor(&per_cu, (const void*)mk_fwd, NWAVES * 64, LDS_BYTES) != hipSuccess || per_cu < 1) { fprintf(stderr, "kernel_launch: occupancy query says %d blocks per CU\n", per_cu); (void)hipGetLastError(); grid = -1; return; }
        grid = cus;
    }
    if (grid < 0) return;
    (void)hipMemsetAsync((char*)d_ws + WS_CTL, 0, CTL_BYTES, stream);
    Args a{};
    const float** pp = (const float**)&a.P;
    for (int i = 0; i < 24; ++i) pp[i] = (const float*)d_in[i];
    a.P.out = (float*)d_out; a.P.ws = (unsigned char*)d_ws;
    if (MK_N_LAUNCHES == 1) {
        a.ph_lo = 0; a.ph_hi = N_PHASES;
        void* args[] = {&a};
        hipError_t e = hipLaunchCooperativeKernel((const void*)mk_fwd, dim3(grid), dim3(NWAVES * 64), args, LDS_BYTES, stream);
        if (e != hipSuccess) fprintf(stderr, "kernel_launch: cooperative launch failed: %s (grid %d)\n", hipGetErrorString(e), grid);
    } else {
        for (int k = 0; k < N_PHASES; ++k) { a.ph_lo = k; a.ph_hi = k + 1; hipLaunchKernelGGL(mk_fwd, dim3(grid), dim3(NWAVES * 64), LDS_BYTES, stream, a); }
    }
}
```
